# Optimizing an MI355X kernel written in HIP

```python
import jax, jax.numpy as jnp
from jax import lax
import numpy as np

D_MODEL = 2048
BATCH = 2
SEQ = 16384
DEPTH = 1

HEAD_DIM = 64
N_Q_HEADS = 16
N_KV_HEADS = 2
GQA_GROUP = N_Q_HEADS // N_KV_HEADS
ATTN_WIDTH = N_Q_HEADS * HEAD_DIM
KV_WIDTH = N_KV_HEADS * HEAD_DIM
WINDOW = 128
BLOCK = 128
ROPE_THETA = 10000.0
HG_HEAD_DIM = 128
HG_HEADS = 8
HG_WIDTH = HG_HEADS * HG_HEAD_DIM
CHUNK = 64
D_FF = 5632
N_BRANCH = 2
EPS = 1e-6
IN_SPLITS = (ATTN_WIDTH, KV_WIDTH, KV_WIDTH, HG_WIDTH, HG_WIDTH, HG_WIDTH, HG_WIDTH, N_BRANCH * D_MODEL)
IN_COLS = sum(IN_SPLITS)

kernel_name = 'hybrid_swa_sink_hgrn2_macaron_layer'


def rmsnorm(x, g):
    xf = x.astype(jnp.float32)
    y = xf * lax.rsqrt(jnp.mean(xf * xf, axis=-1, keepdims=True) + EPS)
    return (y * g.astype(jnp.float32)).astype(x.dtype)


def swiglu(h, w_gu, w_down):
    gate, up = jnp.split(h @ w_gu, 2, axis=-1)
    return (jax.nn.silu(gate) * up) @ w_down


def rope(t, positions):
    half = HEAD_DIM // 2
    inv_freq = ROPE_THETA ** (-jnp.arange(half, dtype=jnp.float32) * 2.0 / HEAD_DIM)
    ang = positions.astype(jnp.float32)[..., None] * inv_freq
    cos = jnp.cos(ang)[:, :, None, :]
    sin = jnp.sin(ang)[:, :, None, :]
    t1, t2 = t[..., :half], t[..., half:]
    return jnp.concatenate([t1 * cos - t2 * sin, t2 * cos + t1 * sin], axis=-1)


def sliding_window_attention(q, k, v, sinks):
    B, S = q.shape[0], q.shape[1]
    nb = S // BLOCK
    qb = q.reshape(B, nb, BLOCK, N_KV_HEADS, GQA_GROUP, HEAD_DIM)
    kb = k.reshape(B, nb, BLOCK, N_KV_HEADS, HEAD_DIM)
    vb = v.reshape(B, nb, BLOCK, N_KV_HEADS, HEAD_DIM)

    def with_prev(t):
        prev = jnp.pad(t, ((0, 0), (1, 0), (0, 0), (0, 0), (0, 0)))[:, :-1]
        return jnp.concatenate([prev, t], axis=2)

    kw, vw = with_prev(kb), with_prev(vb)
    scores = jnp.einsum('bnqkgd,bnskd->bnkgqs', qb, kw) * (HEAD_DIM ** -0.5)
    i = jnp.arange(BLOCK)[:, None]
    j = jnp.arange(2 * BLOCK)[None, :]
    band = (j <= i + BLOCK) & (j > i + BLOCK - WINDOW)
    blk = jnp.arange(nb)[:, None, None]
    valid = band[None] & (blk * BLOCK + j[None] - BLOCK >= 0)
    scores = jnp.where(valid[None, :, None, None], scores, -jnp.inf)
    sink = sinks.astype(jnp.float32).reshape(N_KV_HEADS, GQA_GROUP)[None, None, :, :, None, None]
    m = jnp.maximum(jnp.max(scores, axis=-1, keepdims=True), sink)
    p = jnp.exp(scores - m)
    denom = jnp.sum(p, axis=-1, keepdims=True) + jnp.exp(sink - m)
    out = jnp.einsum('bnkgqs,bnskd->bnqkgd', p / denom, vw)
    return out.reshape(B, S, ATTN_WIDTH)


def hgrn2(q, f_logit, inp, lb):
    B, S = q.shape[0], q.shape[1]
    nc = S // CHUNK

    def heads(t):
        return t.astype(jnp.float32).reshape(B, nc, CHUNK, HG_HEADS, HG_HEAD_DIM).transpose(0, 3, 1, 2, 4)

    f = lb + (1.0 - lb) * jax.nn.sigmoid(f_logit.astype(jnp.float32))
    qh = heads(jax.nn.silu(q.astype(jnp.float32)))
    kh = heads(1.0 - f)
    vh = heads(inp)
    b = jnp.cumsum(heads(jnp.log(f)), axis=3)
    b_ref = b[:, :, :, CHUNK // 2:CHUNK // 2 + 1]
    attn = jnp.einsum('bhncd,bhnsd->bhncs', qh * jnp.exp(b - b_ref), kh * jnp.exp(b_ref - b))
    causal = jnp.tril(jnp.ones((CHUNK, CHUNK), dtype=bool))
    o_intra = jnp.einsum('bhncs,bhnse->bhnce', jnp.where(causal, attn, 0.0), vh)
    b_last = b[:, :, :, -1:]
    upd = jnp.einsum('bhnsd,bhnse->bhnde', kh * jnp.exp(b_last - b), vh)
    decay = jnp.exp(b_last[:, :, :, 0])

    def step(state, xs):
        u_c, d_c = xs
        return d_c[..., None] * state + u_c, state

    s0 = jnp.zeros((B, HG_HEADS, HG_HEAD_DIM, HG_HEAD_DIM), jnp.float32)
    _, s_prev = lax.scan(step, s0, (jnp.moveaxis(upd, 2, 0), jnp.moveaxis(decay, 2, 0)))
    s_prev = jnp.moveaxis(s_prev, 0, 2)
    o_inter = jnp.einsum('bhncd,bhnde->bhnce', qh * jnp.exp(b), s_prev)
    o = o_intra + o_inter
    return o.transpose(0, 2, 3, 1, 4).reshape(B, S, HG_HEADS, HG_HEAD_DIM)


def setup_inputs(seed: int = 0) -> dict:
    key = jax.random.key(seed)
    ks = jax.random.split(key, 20)

    def w(k, shape, fan_in):
        return jax.random.normal(k, shape, jnp.float32) * (fan_in ** -0.5)

    def gain(k, shape):
        return 1.0 + 0.05 * jax.random.normal(k, shape, jnp.float32)

    return {
        'x': jax.random.normal(ks[0], (BATCH, SEQ, D_MODEL), jnp.float32),
        'positions': jnp.tile(jnp.arange(SEQ, dtype=jnp.int32)[None, :], (BATCH, 1)),
        'lb_table': 0.1 * jax.random.normal(ks[1], (DEPTH + 1, HG_WIDTH), jnp.float32),
        'ffn1_norm': gain(ks[2], (DEPTH, D_MODEL)),
        'ffn1_w_gu': w(ks[3], (DEPTH, D_MODEL, 2 * D_FF), D_MODEL),
        'ffn1_w_down': w(ks[4], (DEPTH, D_FF, D_MODEL), D_FF),
        'mix_norm': gain(ks[5], (DEPTH, D_MODEL)),
        'w_in': w(ks[6], (DEPTH, D_MODEL, IN_COLS), D_MODEL),
        'q_norm': gain(ks[7], (DEPTH, HEAD_DIM)),
        'k_norm': gain(ks[8], (DEPTH, HEAD_DIM)),
        'sinks': 0.5 * jax.random.normal(ks[9], (DEPTH, N_Q_HEADS), jnp.float32),
        'hg_out_norm': gain(ks[10], (DEPTH, HG_HEAD_DIM)),
        'w_attn_branch': w(ks[11], (DEPTH, ATTN_WIDTH, D_MODEL), ATTN_WIDTH),
        'w_hg_branch': w(ks[12], (DEPTH, HG_WIDTH, D_MODEL), HG_WIDTH),
        'w_out': w(ks[13], (DEPTH, D_MODEL, D_MODEL), D_MODEL),
        'ffn2_norm': gain(ks[14], (DEPTH, D_MODEL)),
        'ffn2_w_gu': w(ks[15], (DEPTH, D_MODEL, 2 * D_FF), D_MODEL),
        'ffn2_w_down': w(ks[16], (DEPTH, D_FF, D_MODEL), D_FF),
    }


def reference(x, positions, lb_table, ffn1_norm, ffn1_w_gu, ffn1_w_down, mix_norm, w_in, q_norm, k_norm,
              sinks, hg_out_norm, w_attn_branch, w_hg_branch, w_out, ffn2_norm, ffn2_w_gu, ffn2_w_down):
    B, S = x.shape[0], x.shape[1]
    lbs = jnp.cumsum(jax.nn.softmax(lb_table.astype(jnp.float32), axis=0), axis=0)
    split_idx = np.cumsum(IN_SPLITS)[:-1].tolist()
    for l in range(DEPTH):
        x = x + 0.5 * swiglu(rmsnorm(x, ffn1_norm[l]), ffn1_w_gu[l], ffn1_w_down[l])
        h = rmsnorm(x, mix_norm[l])
        z = h @ w_in[l]
        a_q, a_k, a_v, g_q, g_f, g_i, g_o, br = jnp.split(z, split_idx, axis=-1)
        qa = rmsnorm(a_q.astype(jnp.float32).reshape(B, S, N_Q_HEADS, HEAD_DIM), q_norm[l])
        ka = rmsnorm(a_k.astype(jnp.float32).reshape(B, S, N_KV_HEADS, HEAD_DIM), k_norm[l])
        va = a_v.astype(jnp.float32).reshape(B, S, N_KV_HEADS, HEAD_DIM)
        y_attn = sliding_window_attention(rope(qa, positions), rope(ka, positions), va, sinks[l]).astype(x.dtype)
        o_hg = hgrn2(g_q, g_f, g_i, lbs[l])
        gate_hg = jax.nn.silu(g_o.astype(jnp.float32)).reshape(B, S, HG_HEADS, HG_HEAD_DIM)
        y_hg = (rmsnorm(o_hg, hg_out_norm[l]) * gate_hg).reshape(B, S, HG_WIDTH).astype(x.dtype)
        gates = jax.nn.sigmoid(br).reshape(B, S, N_BRANCH, D_MODEL)
        merged = gates[:, :, 0] * (y_attn @ w_attn_branch[l]) + gates[:, :, 1] * (y_hg @ w_hg_branch[l])
        x = x + merged @ w_out[l]
        x = x + 0.5 * swiglu(rmsnorm(x, ffn2_norm[l]), ffn2_w_gu[l], ffn2_w_down[l])
    return x
```

```cpp
#include <hip/hip_runtime.h>
#include <hip/hip_cooperative_groups.h>
#include <cstdio>
#include <cstdint>
namespace cg = cooperative_groups;
constexpr int BATCH = 2, SEQ = 16384, DM = 2048, TT = BATCH * SEQ, DFF = 5632, NGU = 2 * DFF, NIN = 9472;
constexpr int NTHREADS = 512, NWAVES = 8;
constexpr int LDS_BYTES = 147456;
constexpr size_t MiB = 1u << 20;
constexpr size_t WS_WGU1 = 1 * MiB, WS_WD1 = 45 * MiB, WS_WIN = 67 * MiB, WS_WAR = 104 * MiB, WS_WOUT = 112 * MiB, WS_WGU2 = 120 * MiB, WS_WD2 = 164 * MiB;
constexpr size_t WS_ROPE = 186 * MiB, WS_SEGS = 194 * MiB, WS_SEGD = 210 * MiB, WS_H = 212 * MiB, WS_ZA = 340 * MiB, WS_ZH = 420 * MiB, WS_ZG = 676 * MiB, WS_SS = 932 * MiB, WS_END = 936 * MiB;
constexpr size_t WS_HID = WS_ZA, WS_MRG = WS_ZH;

namespace pg8 {
#define PG8_LAS __attribute__((address_space(3)))
typedef unsigned short bf16_t;
typedef short bf16x8 __attribute__((ext_vector_type(8)));
typedef float f32x4 __attribute__((ext_vector_type(4)));
typedef unsigned u32x4 __attribute__((ext_vector_type(4)));
constexpr int BM = 256, BK = 64, HALF = 128, HTB = HALF * BK * 2  , STAGE_BYTES = 8 * HTB, NXCD = 8, WGM = 8;

__host__ __device__ __forceinline__ int lds_byte(int r, int c) { const int st = (r >> 4) * 2 + (c >> 5), rr = r & 15, cc = c & 31, ob = rr * 64 + cc * 2; return st * 1024 + (ob ^ (((ob >> 9) & 1) << 5)); }
__host__ __device__ __forceinline__ void stage_rc(int b, int& R, int& C) { const int st = b / 1024, sb = b % 1024, swz = sb ^ (((sb >> 9) & 1) << 5); R = (st >> 1) * 16 + swz / 64; C = (st & 1) * 32 + (swz % 64) / 2; }
__host__ __device__ __forceinline__ int perm32(int rho) { const int n = rho >> 4, i = rho & 15; return 8 * (i >> 2) + 4 * n + (i & 3); }

struct Unit { int pm, pn, half; };
struct Gemm { const bf16_t* A; const bf16_t* Bt; int M, N, K; const bf16_t* A2; const bf16_t* B2; };

struct StaticOrder {
    int nM, nN, nwg, G, c;
    __host__ __device__ void init(int M, int N, int G_, int c_) { nM = M / BM; nN = N / BM; nwg = nM * nN; G = G_; c = c_; }
    __host__ __device__ bool next(int i, Unit& u) const {
        const long L = (long)i * G + c; if (L >= nwg) return false;
        int wgid = (int)L; { const int q = nwg / NXCD, r = nwg % NXCD, xcd = wgid % NXCD, off = wgid / NXCD; wgid = (xcd < r ? xcd * (q + 1) : r * (q + 1) + (xcd - r) * q) + off; }
        const int nig = WGM * nN, gid = wgid / nig, fm = gid * WGM, gsz = (nM - fm) < WGM ? (nM - fm) : WGM;
        u.pm = fm + ((wgid % nig) % gsz); u.pn = (wgid % nig) / gsz; u.half = 0; return true;
    }
    __device__ __forceinline__ void a_ready(const Unit&) const {}
    __device__ __forceinline__ void done(const Unit&) const {}
};
struct DualOrder {
    StaticOrder base;
    __host__ __device__ bool next(int i, Unit& u) const { if (!base.next(i >> 1, u)) return false; u.half = i & 1; return true; }
    __device__ __forceinline__ void a_ready(const Unit&) const {}
    __device__ __forceinline__ void done(const Unit&) const {}
};
__device__ __forceinline__ unsigned cvt_pk_bf16(float lo, float hi) { unsigned r; asm volatile("v_cvt_pk_bf16_f32 %0, %1, %2" : "=v"(r) : "v"(lo), "v"(hi)); return r; }
typedef float f32x2 __attribute__((ext_vector_type(2)));
__device__ __forceinline__ float fast_exp(float x) { return __builtin_amdgcn_exp2f(x * 1.4426950408889634f); }
__device__ __forceinline__ float fast_log(float x) { return __builtin_amdgcn_logf(x) * 0.6931471805599453f; }
__device__ __forceinline__ float fast_sigmoid(float x) { return __builtin_amdgcn_rcpf(1.0f + fast_exp(-x)); }
__device__ __forceinline__ float fast_silu(float x) { return x * fast_sigmoid(x); }
__device__ __forceinline__ float bf_lo(unsigned w) { return __uint_as_float(w << 16); }
__device__ __forceinline__ float bf_hi(unsigned w) { return __uint_as_float(w & 0xffff0000u); }

struct EpiSwiglu {
    static constexpr bool PERM = true, AFTER_DRAIN = false, MIDHOOK = false, DUAL = false;
    unsigned char* ws; int ssidx;
    __device__ __forceinline__ void operator()(const f32x4 (&acc)[2][2][4][2], const Unit& u, int wr, int wc, int fr, int fq) const {
        const int row0 = u.pm * BM + wr * 64 + fr; const int col0 = u.pn * HALF + wc * 32 + 8 * fq;
        bf16_t* O = (bf16_t*)(ws + WS_HID); const float* SS = (const float*)(ws + WS_SS) + (size_t)ssidx * TT * 8; constexpr int ldc = DFF;
        float rsv[2][4];
        { f32x4 sa[2][4], sb[2][4];
#pragma unroll
          for (int ai = 0; ai < 2; ++ai)
#pragma unroll
              for (int m = 0; m < 4; ++m) { const size_t row = (size_t)(row0 + ai * HALF + m * 16); sa[ai][m] = *(const f32x4*)(SS + row * 8); sb[ai][m] = *(const f32x4*)(SS + row * 8 + 4); }
          asm volatile("" ::: "memory");
#pragma unroll
          for (int ai = 0; ai < 2; ++ai)
#pragma unroll
              for (int m = 0; m < 4; ++m) rsv[ai][m] = rsqrtf((((sa[ai][m][0] + sa[ai][m][1]) + (sa[ai][m][2] + sa[ai][m][3])) + ((sb[ai][m][0] + sb[ai][m][1]) + (sb[ai][m][2] + sb[ai][m][3]))) * (1.0f / 2048.0f) + 1e-6f); }
#pragma unroll
        for (int ai = 0; ai < 2; ++ai)
#pragma unroll
            for (int m = 0; m < 4; ++m) { const int row = row0 + ai * HALF + m * 16; bf16_t* p = O + (size_t)row * ldc + col0;
                const float rs = rsv[ai][m];
                const f32x4 g0 = acc[ai][0][m][0] * rs, g1 = acc[ai][0][m][1] * rs, u0 = acc[ai][1][m][0] * rs, u1 = acc[ai][1][m][1] * rs;
                u32x4 w; w.x = cvt_pk_bf16(fast_silu(g0[0]) * u0[0], fast_silu(g0[1]) * u0[1]); w.y = cvt_pk_bf16(fast_silu(g0[2]) * u0[2], fast_silu(g0[3]) * u0[3]);
                w.z = cvt_pk_bf16(fast_silu(g1[0]) * u1[0], fast_silu(g1[1]) * u1[1]); w.w = cvt_pk_bf16(fast_silu(g1[2]) * u1[2], fast_silu(g1[3]) * u1[3]);
                *(u32x4*)p = w; }
    }
};
typedef unsigned u32x2e __attribute__((ext_vector_type(2)));
template <bool STATS> struct EpiResid {
    static constexpr bool PERM = false, AFTER_DRAIN = false, MIDHOOK = false, DUAL = false;
    const float* base; float* out; float scale; unsigned char* ws; int ssidx;
    __device__ __forceinline__ void operator()(const f32x4 (&acc)[2][2][4][2], const Unit& u, int wr, int wc, int fr, int fq) const {
        const int row0 = u.pm * BM + wr * 64 + fr; const int col0 = u.pn * BM + wc * 32 + 4 * fq;
        bf16_t* XB = (bf16_t*)(ws + WS_H); float* SSn = (float*)(ws + WS_SS) + (size_t)ssidx * TT; constexpr int ldc = DM;
#pragma unroll
        for (int ai = 0; ai < 2; ++ai) {
            f32x4 bv[4][2][2];
#pragma unroll
            for (int m = 0; m < 4; ++m) { const size_t off = (size_t)(row0 + ai * HALF + m * 16) * ldc + col0;
#pragma unroll
                for (int bj = 0; bj < 2; ++bj)
#pragma unroll
                    for (int n = 0; n < 2; ++n) bv[m][bj][n] = *(const f32x4*)(base + off + bj * HALF + n * 16); }
            asm volatile("" ::: "memory");
#pragma unroll
            for (int m = 0; m < 4; ++m) { const int row = row0 + ai * HALF + m * 16; const size_t off = (size_t)row * ldc + col0; float part = 0.f;
#pragma unroll
                for (int bj = 0; bj < 2; ++bj)
#pragma unroll
                    for (int n = 0; n < 2; ++n) { const f32x4 v = bv[m][bj][n] + acc[ai][bj][m][n] * scale; *(f32x4*)(out + off + bj * HALF + n * 16) = v;
                        if (STATS) { u32x2e w; w.x = cvt_pk_bf16(v[0], v[1]); w.y = cvt_pk_bf16(v[2], v[3]); *(u32x2e*)(XB + off + bj * HALF + n * 16) = w; part += (v[0] * v[0] + v[1] * v[1]) + (v[2] * v[2] + v[3] * v[3]); } }
                if (STATS) { part += __shfl_xor(part, 16); part += __shfl_xor(part, 32); if (fq == 0) __hip_atomic_fetch_add(SSn + row, part, __ATOMIC_RELAXED, __HIP_MEMORY_SCOPE_AGENT); } }
        }
    }
};
template <int MODE> struct EpiResidB {
    static constexpr bool PERM = true, AFTER_DRAIN = false, MIDHOOK = false, DUAL = false;
    float* out; float scale; unsigned char* ws; int ssidx; PG8_LAS float* P;
    __device__ __forceinline__ void operator()(const f32x4 (&acc)[2][2][4][2], const Unit& u, int wr, int wc, int fr, int fq) const {
        const int row0 = u.pm * BM + wr * 64 + fr; const int col0 = u.pn * BM + wc * 32 + 8 * fq;
        bf16_t* XB = (bf16_t*)(ws + WS_H); float* SSn = (float*)(ws + WS_SS) + (size_t)ssidx * TT * 8; constexpr int ldc = DM;
#pragma unroll
        for (int ai = 0; ai < 2; ++ai) {
            u32x4 bv[4][2];
#pragma unroll
            for (int m = 0; m < 4; ++m) { const size_t off = (size_t)(row0 + ai * HALF + m * 16) * ldc + col0;
#pragma unroll
                for (int bj = 0; bj < 2; ++bj) bv[m][bj] = *(const u32x4*)(XB + off + bj * HALF); }
            asm volatile("" ::: "memory");
#pragma unroll
            for (int m = 0; m < 4; ++m) { const int row = row0 + ai * HALF + m * 16; const size_t off = (size_t)row * ldc + col0; float part = 0.f;
#pragma unroll
                for (int bj = 0; bj < 2; ++bj) { const u32x4 b = bv[m][bj];
                    const f32x4 v0 = (f32x4){bf_lo(b.x), bf_hi(b.x), bf_lo(b.y), bf_hi(b.y)} + acc[ai][bj][m][0] * scale, v1 = (f32x4){bf_lo(b.z), bf_hi(b.z), bf_lo(b.w), bf_hi(b.w)} + acc[ai][bj][m][1] * scale;
                    if (MODE == 0) {
                        u32x4 w; w.x = cvt_pk_bf16(v0[0], v0[1]); w.y = cvt_pk_bf16(v0[2], v0[3]); w.z = cvt_pk_bf16(v1[0], v1[1]); w.w = cvt_pk_bf16(v1[2], v1[3]);
                        *(u32x4*)(XB + off + bj * HALF) = w;
                        const float r0 = bf_lo(w.x), r1 = bf_hi(w.x), r2 = bf_lo(w.y), r3 = bf_hi(w.y), r4 = bf_lo(w.z), r5 = bf_hi(w.z), r6 = bf_lo(w.w), r7 = bf_hi(w.w);
                        part += ((r0 * r0 + r1 * r1) + (r2 * r2 + r3 * r3)) + ((r4 * r4 + r5 * r5) + (r6 * r6 + r7 * r7));
                    } else { *(f32x4*)(out + off + bj * HALF) = v0; *(f32x4*)(out + off + bj * HALF + 4) = v1; } }
                if (MODE == 0) { part += __shfl_xor(part, 16); part += __shfl_xor(part, 32); if (fq == 0) P[(ai * HALF + wr * 64 + m * 16 + fr) * 4 + wc] = part; } }
        }
        if (MODE == 0) {
            asm volatile("s_waitcnt lgkmcnt(0)" ::: "memory"); __builtin_amdgcn_s_barrier(); asm volatile("" ::: "memory");
            if (wr == 0) { const int rt = wc * 64 + fq * 16 + fr; const f32x4 pv = *(const PG8_LAS f32x4*)(P + rt * 4); SSn[(size_t)(u.pm * BM + rt) * 8 + u.pn] = (pv[0] + pv[1]) + (pv[2] + pv[3]); }
        }
    }
};
struct EpiZ {
    static constexpr bool PERM = true, AFTER_DRAIN = false, MIDHOOK = false, DUAL = false;
    unsigned char* ws;
    __device__ __forceinline__ void operator()(const f32x4 (&acc)[2][2][4][2], const Unit& u, int wr, int wc, int fr, int fq) const {
        bf16_t* ZA = (bf16_t*)(ws + WS_ZA); bf16_t* ZH = (bf16_t*)(ws + WS_ZH); bf16_t* ZG = (bf16_t*)(ws + WS_ZG); const float* SS = (const float*)(ws + WS_SS) + (size_t)TT * 8;
        const int row0 = u.pm * BM + wr * 64 + fr;
        float rsv[2][4];
        { f32x4 sa[2][4], sb[2][4];
#pragma unroll
          for (int ai = 0; ai < 2; ++ai)
#pragma unroll
              for (int m = 0; m < 4; ++m) { const size_t row = (size_t)(row0 + ai * HALF + m * 16); sa[ai][m] = *(const f32x4*)(SS + row * 8); sb[ai][m] = *(const f32x4*)(SS + row * 8 + 4); }
          asm volatile("" ::: "memory");
#pragma unroll
          for (int ai = 0; ai < 2; ++ai)
#pragma unroll
              for (int m = 0; m < 4; ++m) rsv[ai][m] = rsqrtf((((sa[ai][m][0] + sa[ai][m][1]) + (sa[ai][m][2] + sa[ai][m][3])) + ((sb[ai][m][0] + sb[ai][m][1]) + (sb[ai][m][2] + sb[ai][m][3]))) * (1.0f / 2048.0f) + 1e-6f); }
        if (u.pn < 21) {
            bf16_t* basep; int ld, colt;
            if (u.pn < 5) { basep = ZA; ld = 1280; colt = u.pn * BM; } else { basep = ZH; ld = 4096; colt = (u.pn - 5) * BM; }
            const int col0 = colt + wc * 32 + 8 * fq;
#pragma unroll
            for (int ai = 0; ai < 2; ++ai)
#pragma unroll
                for (int m = 0; m < 4; ++m) { const int row = row0 + ai * HALF + m * 16; bf16_t* rowp = basep + (size_t)row * ld + col0;
                    const float rs = rsv[ai][m];
#pragma unroll
                    for (int bj = 0; bj < 2; ++bj) { const f32x4 v0 = acc[ai][bj][m][0] * rs, v1 = acc[ai][bj][m][1] * rs;
                        u32x4 w; w.x = cvt_pk_bf16(v0[0], v0[1]); w.y = cvt_pk_bf16(v0[2], v0[3]); w.z = cvt_pk_bf16(v1[0], v1[1]); w.w = cvt_pk_bf16(v1[2], v1[3]);
                        *(u32x4*)(rowp + bj * HALF) = w; } }
        } else {
            const int col0 = (u.pn - 21) * HALF + wc * 32 + 8 * fq;
#pragma unroll
            for (int ai = 0; ai < 2; ++ai)
#pragma unroll
                for (int m = 0; m < 4; ++m) { const int row = row0 + ai * HALF + m * 16; bf16_t* rowp = ZG + (size_t)row * 4096 + col0;
                    const float rs = rsv[ai][m];
                    float rt[8], gr[8];
#pragma unroll
                    for (int n = 0; n < 2; ++n)
#pragma unroll
                        for (int k = 0; k < 4; ++k) { const float a = acc[ai][0][m][n][k] * rs, b = fmaxf(acc[ai][1][m][n][k] * rs, -60.0f);
                            const float ea = 1.0f + fast_exp(-a), eb = 1.0f + fast_exp(-b); gr[4 * n + k] = __builtin_amdgcn_rcpf(eb); rt[4 * n + k] = eb * __builtin_amdgcn_rcpf(ea); }
                    u32x4 w; w.x = cvt_pk_bf16(rt[0], rt[1]); w.y = cvt_pk_bf16(rt[2], rt[3]); w.z = cvt_pk_bf16(rt[4], rt[5]); w.w = cvt_pk_bf16(rt[6], rt[7]); *(u32x4*)rowp = w;
                    u32x4 g; g.x = cvt_pk_bf16(gr[0], gr[1]); g.y = cvt_pk_bf16(gr[2], gr[3]); g.z = cvt_pk_bf16(gr[4], gr[5]); g.w = cvt_pk_bf16(gr[6], gr[7]); *(u32x4*)(rowp + 2048) = g; }
        }
    }
};
struct EpiMerge {
    static constexpr bool PERM = true, AFTER_DRAIN = false, MIDHOOK = false, DUAL = true;
    unsigned char* ws;
    __device__ __forceinline__ void mid(f32x4 (&acc)[2][2][4][2], const Unit& u, int wr, int wc, int fr, int fq) const {
        const int row0 = u.pm * BM + wr * 64 + fr; const int col0 = u.pn * BM + wc * 32 + 8 * fq;
        const bf16_t* ZG = (const bf16_t*)(ws + WS_ZG);
#pragma unroll
        for (int ai = 0; ai < 2; ++ai) {
            u32x4 gw[4][2];
#pragma unroll
            for (int m = 0; m < 4; ++m) { const size_t r = (size_t)(row0 + ai * HALF + m * 16);
#pragma unroll
                for (int bj = 0; bj < 2; ++bj) gw[m][bj] = *(const u32x4*)(ZG + r * 4096 + col0 + bj * HALF); }
            asm volatile("" ::: "memory");
#pragma unroll
            for (int m = 0; m < 4; ++m)
#pragma unroll
                for (int bj = 0; bj < 2; ++bj) { const u32x4 w = gw[m][bj];
                    acc[ai][bj][m][0] = acc[ai][bj][m][0] * (f32x4){bf_lo(w.x), bf_hi(w.x), bf_lo(w.y), bf_hi(w.y)}; acc[ai][bj][m][1] = acc[ai][bj][m][1] * (f32x4){bf_lo(w.z), bf_hi(w.z), bf_lo(w.w), bf_hi(w.w)}; }
        }
    }
    __device__ __forceinline__ void operator()(const f32x4 (&acc)[2][2][4][2], const Unit& u, int wr, int wc, int fr, int fq) const {
        const int row0 = u.pm * BM + wr * 64 + fr; const int col0 = u.pn * BM + wc * 32 + 8 * fq;
        const bf16_t* ZG = (const bf16_t*)(ws + WS_ZG); bf16_t* O = (bf16_t*)(ws + WS_MRG);
#pragma unroll
        for (int ai = 0; ai < 2; ++ai) {
            u32x4 gw[4][2];
#pragma unroll
            for (int m = 0; m < 4; ++m) { const size_t r = (size_t)(row0 + ai * HALF + m * 16);
#pragma unroll
                for (int bj = 0; bj < 2; ++bj) gw[m][bj] = *(const u32x4*)(ZG + r * 4096 + 2048 + col0 + bj * HALF); }
            asm volatile("" ::: "memory");
#pragma unroll
            for (int m = 0; m < 4; ++m) { const size_t r = (size_t)(row0 + ai * HALF + m * 16);
#pragma unroll
                for (int bj = 0; bj < 2; ++bj) { const u32x4 g = gw[m][bj];
                    const f32x4 v0 = acc[ai][bj][m][0] * (f32x4){bf_lo(g.x), bf_hi(g.x), bf_lo(g.y), bf_hi(g.y)}, v1 = acc[ai][bj][m][1] * (f32x4){bf_lo(g.z), bf_hi(g.z), bf_lo(g.w), bf_hi(g.w)};
                    u32x4 w; w.x = cvt_pk_bf16(v0[0], v0[1]); w.y = cvt_pk_bf16(v0[2], v0[3]); w.z = cvt_pk_bf16(v1[0], v1[1]); w.w = cvt_pk_bf16(v1[2], v1[3]);
                    *(u32x4*)(O + r * 2048 + col0 + bj * HALF) = w; } }
        }
    }
};
template <class Epi, class Sched, bool ALIGN_EPI = false, bool SP2 = false>
__device__ __forceinline__ void gemm_phase(PG8_LAS unsigned char* lds, const Gemm g, const Sched& S, const Epi& E) {
    const int tid = threadIdx.x, wid = __builtin_amdgcn_readfirstlane(tid >> 6), lane = tid & 63, wr = wid >> 2, wc = wid & 3, fr = lane & 15, fq = lane >> 4;
    const int K = g.K, nt = K / BK;
    unsigned voffA[2], voffB[2];
#pragma unroll
    for (int i = 0; i < 2; ++i) { int R, C; stage_rc(tid * 16 + i * 8192, R, C); const int Rb = Epi::PERM ? ((R & ~31) + perm32(R & 31)) : R;
        voffA[i] = (unsigned)(R * K + C) * 2u; voffB[i] = (unsigned)(Rb * K + C) * 2u; }
    const size_t kstep = (size_t)(BK * 2);
    const size_t hstep = (size_t)HALF * K * 2;
    const size_t tstep = 2 * hstep;
    const unsigned ldsw = (unsigned)wid * 1024u;
    const int aoff = lds_byte(wr * 64 + fr, fq * 8), boff = lds_byte(wc * 32 + fr, fq * 8);
#define PG8_SA(b, h) (((b) * 2 + (h)) * HTB)
#define PG8_SB(b, h) ((4 + (b) * 2 + (h)) * HTB)
#define PG8_STAGE(bufoff, gbase, voff) do { _Pragma("unroll") for (int _i = 0; _i < 2; ++_i) \
        __builtin_amdgcn_global_load_lds((const unsigned*)((const char*)(gbase) + (voff)[_i]), (PG8_LAS unsigned*)(lds + (bufoff) + ldsw + _i * 8192), 16, 0, 0); } while (0)
#define PG8_LDA(dst, b, h) do { _Pragma("unroll") for (int m = 0; m < 4; ++m) _Pragma("unroll") for (int k = 0; k < 2; ++k) dst[m][k] = *(const PG8_LAS bf16x8*)(lds + PG8_SA(b, h) + aoff + m * 2048 + k * 1024); } while (0)
#define PG8_LDB(dst, b, h) do { _Pragma("unroll") for (int n = 0; n < 2; ++n) _Pragma("unroll") for (int k = 0; k < 2; ++k) dst[n][k] = *(const PG8_LAS bf16x8*)(lds + PG8_SB(b, h) + boff + n * 2048 + k * 1024); } while (0)
#define PG8_MMA(ai, bj, At, Bt) do { __builtin_amdgcn_s_setprio(1); _Pragma("unroll") for (int m = 0; m < 4; ++m) _Pragma("unroll") for (int n = 0; n < 2; ++n) _Pragma("unroll") for (int k = 0; k < 2; ++k) \
        acc[ai][bj][m][n] = __builtin_amdgcn_mfma_f32_16x16x32_bf16(Bt[n][k], At[m][k], acc[ai][bj][m][n], 0, 0, 0); __builtin_amdgcn_s_setprio(0); } while (0)
#define PG8_WAIT_V(n) asm volatile("s_waitcnt vmcnt(" #n ")" ::: "memory")
#define PG8_WAIT_L(n) asm volatile("s_waitcnt lgkmcnt(" #n ")" ::: "memory")
#define PG8_BAR __builtin_amdgcn_s_barrier()
#define PG8_SCHED __builtin_amdgcn_sched_barrier(0)
    Unit cur, nxt; int ui = 0;
    if (!S.next(0, cur)) return;
    f32x4 acc[2][2][4][2];
#pragma unroll
    for (int a = 0; a < 2; ++a)
#pragma unroll
        for (int b = 0; b < 2; ++b)
#pragma unroll
            for (int m = 0; m < 4; ++m)
#pragma unroll
                for (int n = 0; n < 2; ++n) acc[a][b][m][n] = (f32x4){0.f, 0.f, 0.f, 0.f};
    bf16x8 At[4][2], B0[2][2], B1[2][2];
    const char* cA = (const char*)((Epi::DUAL && cur.half) ? g.A2 : g.A) + (size_t)cur.pm * tstep; const char* cB = (const char*)((Epi::DUAL && cur.half) ? g.B2 : g.Bt) + (size_t)cur.pn * tstep;
    S.a_ready(cur);
    if constexpr (SP2) {
        PG8_STAGE(PG8_SB(0, 0), cB, voffB); PG8_STAGE(PG8_SB(0, 1), cB + hstep, voffB); PG8_STAGE(PG8_SA(0, 0), cA, voffA); PG8_STAGE(PG8_SA(0, 1), cA + hstep, voffA);
        if (wr == 1) PG8_BAR;
        PG8_WAIT_V(2); PG8_BAR;
        PG8_STAGE(PG8_SB(1, 0), cB + kstep, voffB); PG8_STAGE(PG8_SA(1, 0), cA + kstep, voffA); PG8_STAGE(PG8_SB(1, 1), cB + hstep + kstep, voffB);
        PG8_WAIT_V(6); PG8_BAR;
    } else {
        PG8_STAGE(PG8_SB(0, 0), cB, voffB); PG8_STAGE(PG8_SA(0, 0), cA, voffA); PG8_STAGE(PG8_SB(0, 1), cB + hstep, voffB); PG8_STAGE(PG8_SA(0, 1), cA + hstep, voffA);
        if (wr == 1) PG8_BAR;
        PG8_WAIT_V(4); PG8_BAR;
        PG8_STAGE(PG8_SB(1, 0), cB + kstep, voffB); PG8_STAGE(PG8_SA(1, 0), cA + kstep, voffA); PG8_STAGE(PG8_SB(1, 1), cB + hstep + kstep, voffB);
        PG8_WAIT_V(6); PG8_BAR;
    }
    for (;;) {
        const bool has_next = S.next(ui + 1, nxt);
        const char* nA = has_next ? (const char*)((Epi::DUAL && nxt.half) ? g.A2 : g.A) + (size_t)nxt.pm * tstep : cA; const char* nB = has_next ? (const char*)((Epi::DUAL && nxt.half) ? g.B2 : g.Bt) + (size_t)nxt.pn * tstep : cB;
        for (int t = 0; t < nt; t += 2) {
            const bool last = (t == nt - 2);
            const char* a1 = cA + (size_t)(t + 1) * kstep;
            const char* a2 = last ? nA : cA + (size_t)(t + 2) * kstep; const char* b2 = last ? nB : cB + (size_t)(t + 2) * kstep;
            const char* a3 = a2 + kstep; const char* b3 = b2 + kstep;
            if (last && has_next) S.a_ready(nxt);
            if constexpr (SP2) {
            PG8_LDB(B0, 0, 0); PG8_LDB(B1, 0, 1); PG8_SCHED; PG8_LDA(At, 0, 0); PG8_STAGE(PG8_SA(1, 1), a1 + hstep, voffA);
            PG8_WAIT_V(8); PG8_WAIT_L(0); PG8_BAR; PG8_MMA(0, 0, At, B0); PG8_MMA(0, 1, At, B1); PG8_BAR; PG8_SCHED;
            PG8_LDA(At, 0, 1); PG8_STAGE(PG8_SB(0, 0), b2, voffB); PG8_STAGE(PG8_SB(0, 1), b2 + hstep, voffB); PG8_STAGE(PG8_SA(0, 0), a2, voffA);
            PG8_WAIT_V(8); PG8_WAIT_L(0); PG8_BAR; PG8_MMA(1, 0, At, B0); PG8_MMA(1, 1, At, B1); PG8_BAR; PG8_SCHED;
            PG8_LDB(B0, 1, 0); PG8_LDB(B1, 1, 1); PG8_SCHED; PG8_LDA(At, 1, 0); PG8_STAGE(PG8_SA(0, 1), a2 + hstep, voffA);
            PG8_WAIT_V(8); PG8_WAIT_L(0); PG8_BAR; PG8_MMA(0, 0, At, B0); PG8_MMA(0, 1, At, B1); PG8_BAR; PG8_SCHED;
            PG8_LDA(At, 1, 1); PG8_STAGE(PG8_SB(1, 0), b3, voffB); PG8_STAGE(PG8_SB(1, 1), b3 + hstep, voffB); PG8_STAGE(PG8_SA(1, 0), a3, voffA);
            PG8_WAIT_V(8); PG8_WAIT_L(0); PG8_BAR; PG8_MMA(1, 0, At, B0); PG8_MMA(1, 1, At, B1); PG8_BAR; PG8_SCHED;
            } else {
            PG8_LDB(B0, 0, 0); PG8_SCHED; PG8_LDA(At, 0, 0); PG8_STAGE(PG8_SA(1, 1), a1 + hstep, voffA);
            PG8_WAIT_L(8); PG8_BAR; PG8_WAIT_L(0); PG8_MMA(0, 0, At, B0); PG8_BAR; PG8_SCHED;
            PG8_LDB(B1, 0, 1); PG8_STAGE(PG8_SB(0, 0), b2, voffB);
            PG8_BAR; PG8_WAIT_L(0); PG8_MMA(0, 1, At, B1); PG8_BAR;
            PG8_LDA(At, 0, 1); PG8_STAGE(PG8_SA(0, 0), a2, voffA);
            PG8_BAR; PG8_WAIT_L(0); PG8_MMA(1, 0, At, B0); PG8_BAR; PG8_SCHED;
            PG8_STAGE(PG8_SB(0, 1), b2 + hstep, voffB);
            PG8_WAIT_V(6); PG8_BAR; PG8_MMA(1, 1, At, B1); PG8_BAR;
            PG8_LDB(B0, 1, 0); PG8_SCHED; PG8_LDA(At, 1, 0); PG8_STAGE(PG8_SA(0, 1), a2 + hstep, voffA);
            PG8_WAIT_L(8); PG8_BAR; PG8_WAIT_L(0); PG8_MMA(0, 0, At, B0); PG8_BAR; PG8_SCHED;
            PG8_LDB(B1, 1, 1); PG8_STAGE(PG8_SB(1, 0), b3, voffB);
            PG8_BAR; PG8_WAIT_L(0); PG8_MMA(0, 1, At, B1); PG8_BAR;
            PG8_LDA(At, 1, 1); PG8_STAGE(PG8_SA(1, 0), a3, voffA);
            PG8_BAR; PG8_WAIT_L(0); PG8_MMA(1, 0, At, B0); PG8_BAR; PG8_SCHED;
            PG8_STAGE(PG8_SB(1, 1), b3 + hstep, voffB);
            PG8_WAIT_V(6); PG8_BAR; PG8_MMA(1, 1, At, B1); PG8_BAR;
            }
        }
        if constexpr (ALIGN_EPI) { if (wr == 0) PG8_BAR; }
        const bool first_half = Epi::DUAL && cur.half == 0;
        if constexpr (Epi::DUAL) { if (first_half) E.mid(acc, cur, wr, wc, fr, fq); else E(acc, cur, wr, wc, fr, fq); }
        else if constexpr (!Epi::AFTER_DRAIN) { E(acc, cur, wr, wc, fr, fq); S.done(cur); }
        if (!has_next) break;
        if (!first_half)
#pragma unroll
        for (int a = 0; a < 2; ++a)
#pragma unroll
            for (int b = 0; b < 2; ++b)
#pragma unroll
                for (int m = 0; m < 4; ++m)
#pragma unroll
                    for (int n = 0; n < 2; ++n) acc[a][b][m][n] = (f32x4){0.f, 0.f, 0.f, 0.f};
        cur = nxt; cA = nA; cB = nB; ++ui;
        if constexpr (ALIGN_EPI) { if (wr == 1) PG8_BAR; }
    }
    PG8_WAIT_V(0);
    if constexpr (!ALIGN_EPI) { if (wr == 0) PG8_BAR; }
    PG8_BAR;
    if constexpr (Epi::AFTER_DRAIN) { E.fused(acc, cur, wr, wc, fr, fq, lds, wid, lane); S.done(cur); }
#undef PG8_SA
#undef PG8_SB
#undef PG8_STAGE
#undef PG8_LDA
#undef PG8_LDB
#undef PG8_MMA
#undef PG8_WAIT_V
#undef PG8_WAIT_L
#undef PG8_BAR
#undef PG8_SCHED
}
}

using pg8::bf16_t; using pg8::f32x4; using pg8::u32x4; using pg8::cvt_pk_bf16; using pg8::bf_lo; using pg8::bf_hi; using pg8::fast_sigmoid; using pg8::fast_silu; using pg8::fast_exp; using pg8::fast_log;
#define LAS __attribute__((address_space(3)))
typedef unsigned u32x2 __attribute__((ext_vector_type(2)));
typedef float f32x2v __attribute__((ext_vector_type(2)));
struct Args {
    const float* x; const int* pos; const float* lb; const float* n1; const float* wgu1; const float* wd1; const float* nmix; const float* win; const float* qn; const float* kn;
    const float* sinks; const float* hgn; const float* wa; const float* wr; const float* wout; const float* n2; const float* wgu2; const float* wd2; float* out; unsigned char* ws; int ph_lo, ph_hi;
};

__device__ __forceinline__ float wave_sum(float v) {
#pragma unroll
    for (int o = 1; o < 64; o <<= 1) v += __shfl_xor(v, o);
    return v;
}
template <int MODE> __device__ __forceinline__ void transpose_item(const float* W, int K, int N, bf16_t* WT, int ldk, int koff, const float* gain, LAS float* scr, int item, int lane) {
    const int nblk = N / 32, kb = item / nblk, nb = item % nblk, k0 = 64 * kb, n0 = 32 * nb;
    float v[32];
#pragma unroll
    for (int i = 0; i < 32; ++i) { const int kk = 2 * i + (lane >> 5); v[i] = __builtin_nontemporal_load(W + (size_t)(k0 + kk) * N + n0 + (lane & 31)); }
    if (gain) {
#pragma unroll
        for (int i = 0; i < 32; ++i) v[i] *= gain[k0 + 2 * i + (lane >> 5)]; }
#pragma unroll
    for (int i = 0; i < 32; ++i) { const int kk = 2 * i + (lane >> 5); scr[kk * 33 + (lane & 31)] = v[i]; }
    asm volatile("s_waitcnt lgkmcnt(0)" ::: "memory");
    int r0 = n0;
    if (MODE == 1) { const int j = n0 < DFF ? n0 : n0 - DFF; r0 = 256 * (j >> 7) + (j & 127) + (n0 < DFF ? 0 : 128); }
    if (MODE == 2 && n0 >= 5376) { const int q = n0 - 5376, br = q >> 11, c = q & 2047; r0 = 5376 + 256 * (c >> 7) + 128 * br + (c & 127); }
    const int c = lane & 7;
#pragma unroll
    for (int j = 0; j < 4; ++j) { const int n = (lane >> 3) + 8 * j; const LAS float* s = scr + (8 * c) * 33 + n;
        u32x4 o; o.x = cvt_pk_bf16(s[0 * 33], s[1 * 33]); o.y = cvt_pk_bf16(s[2 * 33], s[3 * 33]); o.z = cvt_pk_bf16(s[4 * 33], s[5 * 33]); o.w = cvt_pk_bf16(s[6 * 33], s[7 * 33]);
        *(u32x4*)(WT + (size_t)(r0 + n) * ldk + koff + k0 + 8 * c) = o; }
    asm volatile("s_waitcnt lgkmcnt(0)" ::: "memory");
}
__device__ __forceinline__ void row_to_bf16_ss(const float* xrow, bf16_t* orow, float* ss, int lane) {
    const f32x4* xr = (const f32x4*)xrow + lane;
    f32x4 v[8]; float s = 0.f;
#pragma unroll
    for (int j = 0; j < 8; ++j) { v[j] = __builtin_nontemporal_load(xr + 64 * j); s += (v[j].x * v[j].x + v[j].y * v[j].y) + (v[j].z * v[j].z + v[j].w * v[j].w); }
    s = wave_sum(s); if (lane < 8) ss[lane] = lane == 0 ? s : 0.f;
    u32x2* o8 = (u32x2*)orow + lane;
#pragma unroll
    for (int j = 0; j < 8; ++j) { u32x2 w; w.x = cvt_pk_bf16(v[j].x, v[j].y); w.y = cvt_pk_bf16(v[j].z, v[j].w); o8[64 * j] = w; }
}
typedef short bf16x8 __attribute__((ext_vector_type(8)));
typedef float f32x16 __attribute__((ext_vector_type(16)));
typedef __bf16 bf16x2_t __attribute__((ext_vector_type(2)));
__device__ __forceinline__ unsigned pk_bf16(float lo, float hi) { const f32x2v v = {lo, hi}; const bf16x2_t b = __builtin_convertvector(v, bf16x2_t); return __builtin_bit_cast(unsigned, b); }
__device__ __forceinline__ int crow(int i, int h) { return (i & 3) + 8 * (i >> 2) + 4 * h; }
#define MFMA32(a, b, c) __builtin_amdgcn_mfma_f32_32x32x16_bf16((a), (b), (c), 0, 0, 0)
__device__ __forceinline__ void attn_phase(LAS unsigned char* lds, const bf16_t* ZA, const f32x2v* rope, const float* qn, const float* kn, const float* sinks, bf16_t* Y, int G, int bid, int tid) {
    constexpr int KST = 144, VST = 520;
    LAS unsigned char* Kb = lds; LAS unsigned char* Vt = lds + 256 * KST;
    const int lane = tid & 63, wave = tid >> 6, r = lane & 31, h = lane >> 5;
    for (int u = bid; u < 512; u += G) {
        const int b = u >> 8, nb = (u >> 1) & 127, kvh = u & 1;
        __syncthreads();
        {
            const int j = tid & 255; const int t = nb * 128 - 128 + j; const bool isV = tid >= 256;
            u32x4 raw[8];
#pragma unroll
            for (int c = 0; c < 8; ++c) raw[c] = (u32x4){0u, 0u, 0u, 0u};
            if (t >= 0) { const bf16_t* src = ZA + (size_t)(b * SEQ + t) * 1280 + (isV ? 1152 : 1024) + kvh * 64;
#pragma unroll
                for (int c = 0; c < 8; ++c) raw[c] = ((const u32x4*)src)[c]; }
            if (isV) {
#pragma unroll
                for (int c = 0; c < 8; ++c)
#pragma unroll
                    for (int k = 0; k < 4; ++k) { const unsigned w = raw[c][k]; const int d = 8 * c + 2 * k;
                        *(LAS unsigned short*)(Vt + d * VST + 2 * j) = (unsigned short)(w & 0xffffu); *(LAS unsigned short*)(Vt + (d + 1) * VST + 2 * j) = (unsigned short)(w >> 16); }
            } else {
                float x[64];
#pragma unroll
                for (int c = 0; c < 8; ++c)
#pragma unroll
                    for (int k = 0; k < 4; ++k) { x[8 * c + 2 * k] = bf_lo(raw[c][k]); x[8 * c + 2 * k + 1] = bf_hi(raw[c][k]); }
                if (t >= 0) {
                    float ss = 0.f;
#pragma unroll
                    for (int i = 0; i < 64; ++i) ss += x[i] * x[i];
                    const float rstd = rsqrtf(ss * (1.0f / 64.0f) + 1e-6f);
#pragma unroll
                    for (int i = 0; i < 64; ++i) x[i] = x[i] * rstd * kn[i];
                    const f32x2v* cs = rope + (size_t)(b * SEQ + t) * 32;
#pragma unroll
                    for (int i = 0; i < 32; ++i) { const f32x2v c = cs[i]; const float x1 = x[i], x2 = x[i + 32]; x[i] = x1 * c.x - x2 * c.y; x[i + 32] = x2 * c.x + x1 * c.y; }
                }
#pragma unroll
                for (int c = 0; c < 8; ++c) { u32x4 w; w.x = pk_bf16(x[8 * c], x[8 * c + 1]); w.y = pk_bf16(x[8 * c + 2], x[8 * c + 3]); w.z = pk_bf16(x[8 * c + 4], x[8 * c + 5]); w.w = pk_bf16(x[8 * c + 6], x[8 * c + 7]);
                    *(LAS u32x4*)(Kb + j * KST + 16 * c) = w; }
            }
        }
        __syncthreads();
        const int hq = kvh * 8 + wave; const float sink = sinks[hq];
#pragma unroll 1
        for (int s = 0; s < 4; ++s) {
            const int iq = 32 * s + r; const size_t tokq = (size_t)b * SEQ + nb * 128 + iq;
            bf16x8 qf[4];
            {
                float x[4][8];
#pragma unroll
                for (int kk = 0; kk < 4; ++kk) { const u32x4 w = *(const u32x4*)(ZA + tokq * 1280 + hq * 64 + 16 * kk + 8 * h);
#pragma unroll
                    for (int k = 0; k < 4; ++k) { x[kk][2 * k] = bf_lo(w[k]); x[kk][2 * k + 1] = bf_hi(w[k]); } }
                float ss = 0.f;
#pragma unroll
                for (int kk = 0; kk < 4; ++kk)
#pragma unroll
                    for (int e = 0; e < 8; ++e) ss += x[kk][e] * x[kk][e];
                ss += __shfl_xor(ss, 32);
                const float rstd = rsqrtf(ss * (1.0f / 64.0f) + 1e-6f) * 0.125f;
#pragma unroll
                for (int kk = 0; kk < 4; ++kk)
#pragma unroll
                    for (int e = 0; e < 8; ++e) x[kk][e] = x[kk][e] * rstd * qn[16 * kk + 8 * h + e];
#pragma unroll
                for (int kk = 0; kk < 2; ++kk)
#pragma unroll
                    for (int e = 0; e < 8; ++e) { const f32x2v c = rope[tokq * 32 + 16 * kk + 8 * h + e]; const float x1 = x[kk][e], x2 = x[kk + 2][e]; x[kk][e] = x1 * c.x - x2 * c.y; x[kk + 2][e] = x2 * c.x + x1 * c.y; }
#pragma unroll
                for (int kk = 0; kk < 4; ++kk) { u32x4 w; w.x = pk_bf16(x[kk][0], x[kk][1]); w.y = pk_bf16(x[kk][2], x[kk][3]); w.z = pk_bf16(x[kk][4], x[kk][5]); w.w = pk_bf16(x[kk][6], x[kk][7]); qf[kk] = __builtin_bit_cast(bf16x8, w); }
            }
            f32x16 S[5];
#pragma unroll
            for (int t = 0; t < 5; ++t) { f32x16 acc;
#pragma unroll
                for (int i = 0; i < 16; ++i) acc[i] = 0.f;
#pragma unroll
                for (int kk = 0; kk < 4; ++kk) { const bf16x8 kf = *(const LAS bf16x8*)(Kb + (32 * (s + t) + r) * KST + 32 * kk + 16 * h); acc = MFMA32(kf, qf[kk], acc); }
                S[t] = acc; }
            if (nb > 0) {
#pragma unroll
                for (int i = 0; i < 16; ++i) { const bool up = crow(i, h) > r; S[0][i] = up ? S[0][i] : -INFINITY; S[4][i] = up ? -INFINITY : S[4][i]; }
            } else {
#pragma unroll
                for (int t = 0; t < 5; ++t)
#pragma unroll
                    for (int i = 0; i < 16; ++i) { const int j = 32 * (s + t) + crow(i, h); const bool ok = (j > iq) && (j <= iq + 128) && (j >= 128); S[t][i] = ok ? S[t][i] : -INFINITY; }
            }
            float mx = sink;
#pragma unroll
            for (int t = 0; t < 5; ++t)
#pragma unroll
                for (int i = 0; i < 16; ++i) mx = fmaxf(mx, S[t][i]);
            mx = fmaxf(mx, __shfl_xor(mx, 32));
            float sum = 0.f;
#pragma unroll
            for (int t = 0; t < 5; ++t)
#pragma unroll
                for (int i = 0; i < 16; ++i) { const float p = fast_exp(S[t][i] - mx); S[t][i] = p; sum += p; }
            sum += __shfl_xor(sum, 32); sum += fast_exp(sink - mx);
            f32x16 O0, O1;
#pragma unroll
            for (int i = 0; i < 16; ++i) { O0[i] = 0.f; O1[i] = 0.f; }
#pragma unroll
            for (int t = 0; t < 5; ++t)
#pragma unroll
                for (int ks = 0; ks < 2; ++ks) {
                    u32x4 pw; pw.x = pk_bf16(S[t][8 * ks], S[t][8 * ks + 1]); pw.y = pk_bf16(S[t][8 * ks + 2], S[t][8 * ks + 3]); pw.z = pk_bf16(S[t][8 * ks + 4], S[t][8 * ks + 5]); pw.w = pk_bf16(S[t][8 * ks + 6], S[t][8 * ks + 7]);
                    const bf16x8 pf = __builtin_bit_cast(bf16x8, pw);
                    const int key0 = 32 * (s + t) + 16 * ks + 4 * h;
                    const u32x2 a0 = *(const LAS u32x2*)(Vt + r * VST + 2 * key0), a1 = *(const LAS u32x2*)(Vt + r * VST + 2 * (key0 + 8));
                    const u32x2 c0 = *(const LAS u32x2*)(Vt + (r + 32) * VST + 2 * key0), c1 = *(const LAS u32x2*)(Vt + (r + 32) * VST + 2 * (key0 + 8));
                    const bf16x8 A0 = __builtin_bit_cast(bf16x8, ((u32x4){a0.x, a0.y, a1.x, a1.y})), A1 = __builtin_bit_cast(bf16x8, ((u32x4){c0.x, c0.y, c1.x, c1.y}));
                    O0 = MFMA32(A0, pf, O0); O1 = MFMA32(A1, pf, O1);
                }
            const float inv = 1.0f / sum;
            bf16_t* dst = Y + tokq * 1024 + hq * 64 + 4 * h;
#pragma unroll
            for (int gq = 0; gq < 4; ++gq) {
                u32x2 w0; w0.x = pk_bf16(O0[4 * gq] * inv, O0[4 * gq + 1] * inv); w0.y = pk_bf16(O0[4 * gq + 2] * inv, O0[4 * gq + 3] * inv); *(u32x2*)(dst + 8 * gq) = w0;
                u32x2 w1; w1.x = pk_bf16(O1[4 * gq] * inv, O1[4 * gq + 1] * inv); w1.y = pk_bf16(O1[4 * gq + 2] * inv, O1[4 * gq + 3] * inv); *(u32x2*)(dst + 32 + 8 * gq) = w1; }
        }
    }
}

template <int PASS> __device__ __forceinline__ void hgrn_phase(LAS unsigned char* lds, const bf16_t* ZH, const float* lbt, const float* hgn, float* SEGS, float* SEGD, bf16_t* Y, int G, int bid, int tid) {
    constexpr int O_TQ = 0, O_L0 = 2048, O_DEC = 2560, O_QD = 4096, O_KD = 21504, O_OF = 4096, O_QB = 38912, O_KUT = 56320, O_VT = 74752, O_AM = 93184;
    constexpr int RS = 272, TS = 144, FS = 528;
    LAS float* TQ = (LAS float*)(lds + O_TQ); LAS float* L0 = (LAS float*)(lds + O_L0); LAS float* DEC = (LAS float*)(lds + O_DEC);
    const int lane = tid & 63, wave = tid >> 6, r = lane & 31, h = lane >> 5, cb = wave >> 2, eb = wave & 3;
    const int d = tid & 127, tq = tid >> 7;
    for (int item = bid; item < 256; item += G) {
        const int b = item >> 7, hd = (item >> 4) & 7, seg = item & 15;
        const size_t tok0 = (size_t)b * SEQ + seg * 1024;
        const float lbv = 1.0f / (1.0f + expf(lbt[1024 + hd * 128 + d] - lbt[hd * 128 + d]));
        f32x16 St[4];
#pragma unroll
        for (int db = 0; db < 4; ++db)
#pragma unroll
            for (int i = 0; i < 16; ++i) St[db][i] = 0.f;
        if (PASS == 1) {
            f32x16 Pr[4];
#pragma unroll
            for (int db = 0; db < 4; ++db)
#pragma unroll
                for (int i = 0; i < 16; ++i) Pr[db][i] = 1.0f;
#pragma unroll 1
            for (int sp = seg - 1; sp >= 0; --sp) { const float* Se = SEGS + (size_t)(item - seg + sp) * 16384 + eb * 4096 + lane; const float* De = SEGD + (size_t)(item - seg + sp) * 128;
                float live = 0.f;
#pragma unroll
                for (int db = 0; db < 4; ++db)
#pragma unroll
                    for (int gq = 0; gq < 4; ++gq) { const f32x4 dv = *(const f32x4*)(De + 32 * db + 8 * gq + 4 * h);
#pragma unroll
                        for (int k = 0; k < 4; ++k) { St[db][4 * gq + k] += Pr[db][4 * gq + k] * Se[(db * 16 + 4 * gq + k) * 64]; Pr[db][4 * gq + k] *= dv[k]; live = fmaxf(live, Pr[db][4 * gq + k]); } }
                if (__ballot(live > 0.f) == 0ull) break;
            }
        }
        float Wd = 1.0f;
        LAS unsigned* FLG = (LAS unsigned*)(lds + 3072);
        if (tid == 0) { FLG[0] = 0u; FLG[1] = 0u; }
        unsigned short rq[16], rf[16], ri[16];
        {
            const bf16_t* zp = ZH + (tok0 + (PASS == 0 ? 960 : 0) + 16 * tq) * 4096 + hd * 128 + d;
#pragma unroll
            for (int t = 0; t < 16; ++t) { if (PASS == 1) rq[t] = zp[(size_t)t * 4096]; rf[t] = zp[(size_t)t * 4096 + 1024]; ri[t] = zp[(size_t)t * 4096 + 2048]; }
        }
        __syncthreads();
#pragma unroll 1
        for (int ci = 0; ci < 16; ++ci) {
            const int ch = PASS == 0 ? 15 - ci : ci;
            const size_t tokc = tok0 + 64 * ch;
            float bl[16], kk[16];
#pragma unroll
            for (int t = 0; t < 16; ++t) { const float fl = __uint_as_float((unsigned)rf[t] << 16); const float f = lbv + (1.0f - lbv) * fast_sigmoid(fl); bl[t] = f; kk[t] = 1.0f - f; }
            const float lf0 = bl[0];
#pragma unroll
            for (int t = 1; t < 16; ++t) bl[t] *= bl[t - 1];
            TQ[tq * 128 + d] = bl[15]; if (tq == 2) L0[d] = lf0;
            __syncthreads();
            {
                const float t0 = TQ[d], t1 = TQ[128 + d], t2 = TQ[256 + d], t3 = TQ[384 + d];
                const float off = tq == 0 ? 1.0f : (tq == 1 ? t0 : (tq == 2 ? t0 * t1 : t0 * t1 * t2));
                const float er = t0 * t1 * L0[d], edec = (t0 * t1) * (t2 * t3);
                const float rref = __builtin_amdgcn_rcpf(er), eu = edec * rref, offr = off * rref;
                if (PASS == 1 && tq == 0) DEC[d] = edec;
                const float wk = PASS == 0 ? eu * Wd : eu;
                if (PASS == 0) { Wd *= edec; if (tid == 0) FLG[(ci + 1) & 1] = 0u; if (__ballot(Wd > 0.f) != 0ull && lane == 0) FLG[ci & 1] = 1u; }
                unsigned kuw[8];
#pragma unroll
                for (int t = 0; t < 16; t += 2) {
                    float ku2[2];
#pragma unroll
                    for (int k = 0; k < 2; ++k) {
                        const float ed = offr * bl[t + k], ei = __builtin_amdgcn_rcpf(ed);
                        const float kd = kk[t + k] * ei; ku2[k] = kd * wk;
                        if (PASS == 1) {
                            const float qr = __uint_as_float((unsigned)rq[t + k] << 16); const float qd = fast_silu(qr) * ed;
                            const int row = (16 * tq + t + k) * RS + 2 * d;
                            *(LAS unsigned short*)(lds + O_QD + row) = (unsigned short)(pk_bf16(qd, 0.f) & 0xffffu);
                            *(LAS unsigned short*)(lds + O_KD + row) = (unsigned short)(pk_bf16(kd, 0.f) & 0xffffu);
                            *(LAS unsigned short*)(lds + O_QB + row) = (unsigned short)(pk_bf16(qd * er, 0.f) & 0xffffu);
                        }
                    }
                    kuw[t >> 1] = pk_bf16(ku2[0], ku2[1]);
                    *(LAS unsigned short*)(lds + O_VT + d * TS + 2 * (16 * tq + t)) = ri[t]; *(LAS unsigned short*)(lds + O_VT + d * TS + 2 * (16 * tq + t + 1)) = ri[t + 1];
                }
                *(LAS u32x4*)(lds + O_KUT + d * TS + 32 * tq) = (u32x4){kuw[0], kuw[1], kuw[2], kuw[3]}; *(LAS u32x4*)(lds + O_KUT + d * TS + 32 * tq + 16) = (u32x4){kuw[4], kuw[5], kuw[6], kuw[7]};
            }
            if (ci < 15) { const bf16_t* zp = ZH + (PASS == 0 ? tokc - 64 : tokc + 64) * 4096 + (size_t)(16 * tq) * 4096 + hd * 128 + d;
#pragma unroll
                for (int t = 0; t < 16; ++t) { if (PASS == 1) rq[t] = zp[(size_t)t * 4096]; rf[t] = zp[(size_t)t * 4096 + 1024]; ri[t] = zp[(size_t)t * 4096 + 2048]; } }
            u32x4 go0 = (u32x4){0u, 0u, 0u, 0u}, go1 = go0;
            if (PASS == 1) { const bf16_t* gp = ZH + (tokc + (tid >> 3)) * 4096 + 3072 + hd * 128 + 16 * (tid & 7); go0 = *(const u32x4*)gp; go1 = *(const u32x4*)(gp + 8); }
            __syncthreads();
            const bool alive = PASS == 1 || FLG[ci & 1] != 0u;
            bf16x8 vf[4];
#pragma unroll
            for (int ks = 0; ks < 4; ++ks) vf[ks] = *(const LAS bf16x8*)(lds + O_VT + (32 * eb + r) * TS + 32 * ks + 16 * h);
            if (PASS == 1) {
                if (wave < 4) {
                    const int sb = wave >> 1, cbk = wave & 1;
                    f32x16 acc;
#pragma unroll
                    for (int i = 0; i < 16; ++i) acc[i] = 0.f;
#pragma unroll
                    for (int ks = 0; ks < 8; ++ks) { const bf16x8 kdf = *(const LAS bf16x8*)(lds + O_KD + (32 * sb + r) * RS + 32 * ks + 16 * h), qdf = *(const LAS bf16x8*)(lds + O_QD + (32 * cbk + r) * RS + 32 * ks + 16 * h);
                        acc = MFMA32(kdf, qdf, acc); }
                    const int c = 32 * cbk + r;
#pragma unroll
                    for (int gq = 0; gq < 4; ++gq) { const int s0 = 32 * sb + 8 * gq + 4 * h;
                        const float a0 = (s0 <= c) ? acc[4 * gq] : 0.f, a1 = (s0 + 1 <= c) ? acc[4 * gq + 1] : 0.f, a2 = (s0 + 2 <= c) ? acc[4 * gq + 2] : 0.f, a3 = (s0 + 3 <= c) ? acc[4 * gq + 3] : 0.f;
                        u32x2 w; w.x = pk_bf16(a0, a1); w.y = pk_bf16(a2, a3); *(LAS u32x2*)(lds + O_AM + c * TS + 2 * s0) = w; }
                }
                __syncthreads();
                f32x16 acc;
#pragma unroll
                for (int i = 0; i < 16; ++i) acc[i] = 0.f;
#pragma unroll
                for (int ks = 0; ks < 4; ++ks) { const bf16x8 af = *(const LAS bf16x8*)(lds + O_AM + (32 * cb + r) * TS + 32 * ks + 16 * h); acc = MFMA32(af, vf[ks], acc); }
#pragma unroll
                for (int db = 0; db < 4; ++db)
#pragma unroll
                    for (int k2 = 0; k2 < 2; ++k2) {
                        u32x4 pw; pw.x = pk_bf16(St[db][8 * k2], St[db][8 * k2 + 1]); pw.y = pk_bf16(St[db][8 * k2 + 2], St[db][8 * k2 + 3]); pw.z = pk_bf16(St[db][8 * k2 + 4], St[db][8 * k2 + 5]); pw.w = pk_bf16(St[db][8 * k2 + 6], St[db][8 * k2 + 7]);
                        const int d0 = 32 * db + 16 * k2 + 4 * h;
                        const u32x2 q0 = *(const LAS u32x2*)(lds + O_QB + (32 * cb + r) * RS + 2 * d0), q1 = *(const LAS u32x2*)(lds + O_QB + (32 * cb + r) * RS + 2 * (d0 + 8));
                        acc = MFMA32(__builtin_bit_cast(bf16x8, ((u32x4){q0.x, q0.y, q1.x, q1.y})), __builtin_bit_cast(bf16x8, pw), acc);
                    }
#pragma unroll
                for (int i = 0; i < 16; ++i) *(LAS float*)(lds + O_OF + (32 * cb + crow(i, h)) * FS + 4 * (32 * eb + r)) = acc[i];
            }
#pragma unroll
            for (int db = 0; db < 4; ++db) {
                if (PASS == 1) {
#pragma unroll
                    for (int gq = 0; gq < 4; ++gq) { const f32x4 dv = *(const LAS f32x4*)(DEC + 32 * db + 8 * gq + 4 * h);
#pragma unroll
                        for (int k = 0; k < 4; ++k) St[db][4 * gq + k] *= dv[k]; }
                }
#pragma unroll
                for (int ks = 0; ks < 4; ++ks) { const bf16x8 kf = *(const LAS bf16x8*)(lds + O_KUT + (32 * db + r) * TS + 32 * ks + 16 * h); St[db] = MFMA32(kf, vf[ks], St[db]); }
            }
            if (PASS == 1) {
                __syncthreads();
                const int tk = tid >> 3, cg = tid & 7;
                f32x4 o[4];
#pragma unroll
                for (int k = 0; k < 4; ++k) o[k] = *(const LAS f32x4*)(lds + O_OF + tk * FS + 64 * cg + 16 * k);
                float ss = 0.f;
#pragma unroll
                for (int k = 0; k < 4; ++k) ss += (o[k].x * o[k].x + o[k].y * o[k].y) + (o[k].z * o[k].z + o[k].w * o[k].w);
                ss += __shfl_xor(ss, 1); ss += __shfl_xor(ss, 2); ss += __shfl_xor(ss, 4);
                const float rstd = rsqrtf(ss * (1.0f / 128.0f) + 1e-6f);
                const unsigned gw8[8] = {go0.x, go0.y, go0.z, go0.w, go1.x, go1.y, go1.z, go1.w};
                unsigned ow[8];
#pragma unroll
                for (int k = 0; k < 4; ++k) { const f32x4 gn = *(const f32x4*)(hgn + 16 * cg + 4 * k);
                    ow[2 * k] = pk_bf16(o[k].x * rstd * gn.x * fast_silu(bf_lo(gw8[2 * k])), o[k].y * rstd * gn.y * fast_silu(bf_hi(gw8[2 * k])));
                    ow[2 * k + 1] = pk_bf16(o[k].z * rstd * gn.z * fast_silu(bf_lo(gw8[2 * k + 1])), o[k].w * rstd * gn.w * fast_silu(bf_hi(gw8[2 * k + 1]))); }
                bf16_t* yp = Y + (tokc + tk) * 1024 + hd * 128 + 16 * cg;
                *(u32x4*)yp = (u32x4){ow[0], ow[1], ow[2], ow[3]}; *(u32x4*)(yp + 8) = (u32x4){ow[4], ow[5], ow[6], ow[7]};
            }
            if (!alive) break;
        }
        if (PASS == 0) {
            if (cb == 0) { float* Se = SEGS + (size_t)item * 16384 + eb * 4096 + lane;
#pragma unroll
                for (int db = 0; db < 4; ++db)
#pragma unroll
                    for (int i = 0; i < 16; ++i) Se[(db * 16 + i) * 64] = St[db][i]; }
            if (tq == 0) SEGD[(size_t)item * 128 + d] = Wd;
        }
        __syncthreads();
    }
}

#define XB_TMO      128
#define XB_XCNT(j)  (256  + 64 * (j))
#define XB_XSUB(j)  (1280 + 64 * (j))
#define XB_XGEN(j)  (2304 + 64 * (j))
#define XB_TOP      3328
#define XB_TOPGEN   3392
#define XCD_BAR_WORDS 3456
#define XB_SPIN_CAP (1u << 18)

__device__ __forceinline__ unsigned xb_ld(unsigned* p)              { return __hip_atomic_load(p, __ATOMIC_RELAXED, __HIP_MEMORY_SCOPE_AGENT); }
__device__ __forceinline__ unsigned xb_add(unsigned* p, unsigned v) { return __hip_atomic_fetch_add(p, v, __ATOMIC_RELAXED, __HIP_MEMORY_SCOPE_AGENT); }
__device__ __forceinline__ unsigned xb_xcc_id() { return (unsigned)__builtin_amdgcn_s_getreg((3 << 11) | 20) & 0xFu; }
#define XB_SPIN(cond, bar) do { unsigned _sp = 0; while (cond) { __builtin_amdgcn_s_sleep(1); \
    if ((++_sp & 255u) == 0u) { if (xb_ld(&(bar)[XB_TMO])) break; if (_sp > XB_SPIN_CAP) { atomicAdd(&(bar)[XB_TMO], 1u); break; } } } } while (0)

struct XcdBarrier {
    unsigned* bar; unsigned x;
    volatile LAS unsigned* st;
};

__device__ __forceinline__ XcdBarrier xcd_barrier_post(unsigned* bar, volatile LAS unsigned* st) {
    XcdBarrier b; b.bar = bar; b.x = xb_xcc_id(); b.st = st;
    if (threadIdx.x == 0) (void)xb_add(&bar[XB_XCNT(b.x)], 1u);
    return b;
}
__device__ __forceinline__ void xcd_barrier_complete(unsigned* bar, unsigned x, unsigned& nloc, unsigned& nx) {
    const unsigned G = gridDim.x * gridDim.y * gridDim.z;
    unsigned sum, cnt, mine, sp = 0u;
    for (;;) {
        sum = 0u; cnt = 0u; mine = 0u;
#pragma unroll
        for (unsigned j = 0; j < 16; ++j) { const unsigned c = xb_ld(&bar[XB_XCNT(j)]); sum += c; cnt += (c > 0u) ? 1u : 0u; mine = (j == x) ? c : mine; }
        if (sum == G) break;
        __builtin_amdgcn_s_sleep(1);
        if ((++sp & 255u) == 0u) { if (xb_ld(&bar[XB_TMO])) break; if (sp > XB_SPIN_CAP) { atomicAdd(&bar[XB_TMO], 1u); break; } }
    }
    nloc = mine > 0u ? mine : 1u; nx = cnt > 0u ? cnt : 1u;
}

__device__ __forceinline__ void xcd_barrier(const XcdBarrier& b) {
    asm volatile("s_waitcnt vmcnt(0)" ::: "memory");
    __syncthreads();
    if (threadIdx.x == 0) {
        unsigned* bar = b.bar;
        __builtin_amdgcn_s_waitcnt(0);
        unsigned nloc = b.st[0], nx = b.st[1];
        if (nloc == 0u) { xcd_barrier_complete(bar, b.x, nloc, nx); b.st[0] = nloc; b.st[1] = nx; }
        const unsigned old = xb_add(&bar[XB_XSUB(b.x)], 1u);
        const unsigned gen = old / nloc;
        if (old + 1u == (gen + 1u) * nloc) {
            __builtin_amdgcn_fence(__ATOMIC_RELEASE, "agent");
            asm volatile("s_waitcnt vmcnt(0)" ::: "memory");
            const unsigned og = xb_add(&bar[XB_TOP], 1u);
            const unsigned tg = og / nx;
            if (og + 1u == (tg + 1u) * nx) xb_add(&bar[XB_TOPGEN], 1u);
            else XB_SPIN(xb_ld(&bar[XB_TOPGEN]) == tg, bar);
            __builtin_amdgcn_fence(__ATOMIC_ACQUIRE, "agent");
            xb_add(&bar[XB_XGEN(b.x)], 1u);
            asm volatile("s_waitcnt vmcnt(0)" ::: "memory");
        } else {
            XB_SPIN(xb_ld(&bar[XB_XGEN(b.x)]) == gen, bar);
            __builtin_amdgcn_fence(__ATOMIC_ACQUIRE, "agent");
            asm volatile("s_waitcnt vmcnt(0)" ::: "memory");
        }
    }
    __syncthreads();
}

__global__ void __launch_bounds__(NTHREADS, 2) fwd_megakernel(Args a) {
    extern __shared__ __attribute__((aligned(16))) unsigned char lds_raw[];
    LAS unsigned char* lds = (LAS unsigned char*)lds_raw;
    cg::grid_group grid = cg::this_grid();
    const int tid = threadIdx.x, lane = tid & 63, wave = __builtin_amdgcn_readfirstlane(tid >> 6);
    const int G = gridDim.x, bid = blockIdx.x;
    const int gw = bid * NWAVES + wave, ngw = G * NWAVES;
    unsigned char* ws = a.ws;
    bf16_t* WGU1 = (bf16_t*)(ws + WS_WGU1); bf16_t* WD1 = (bf16_t*)(ws + WS_WD1); bf16_t* WIN = (bf16_t*)(ws + WS_WIN); bf16_t* WAR = (bf16_t*)(ws + WS_WAR);
    bf16_t* WOUT = (bf16_t*)(ws + WS_WOUT); bf16_t* WGU2 = (bf16_t*)(ws + WS_WGU2); bf16_t* WD2 = (bf16_t*)(ws + WS_WD2);
    f32x2v* ROPE = (f32x2v*)(ws + WS_ROPE); float* SEGS = (float*)(ws + WS_SEGS); float* SEGD = (float*)(ws + WS_SEGD);
    bf16_t* H = (bf16_t*)(ws + WS_H); bf16_t* ZA = (bf16_t*)(ws + WS_ZA); bf16_t* ZH = (bf16_t*)(ws + WS_ZH); bf16_t* ZG = (bf16_t*)(ws + WS_ZG);
    float* SS1 = (float*)(ws + WS_SS);
    bf16_t* HID = (bf16_t*)(ws + WS_HID); bf16_t* MRG = (bf16_t*)(ws + WS_MRG); bf16_t* YA = (bf16_t*)a.out; bf16_t* YR = YA + (size_t)TT * 1024;
    const int lo = a.ph_lo, hi = a.ph_hi;
    const int p4_rem = ((TT / 256) * (NIN / 256)) % G; const bool ffn2_deferred = p4_rem != 0;
    volatile LAS unsigned* MISC = (volatile LAS unsigned*)(lds + LDS_BYTES - 64);
    if (tid < 16) MISC[tid] = 0u;
    __syncthreads();
    const XcdBarrier xbar = xcd_barrier_post((unsigned*)ws, MISC + 8);
#ifndef TESTMASK
#define TESTMASK 0xfff
#endif
#define IN(k) (((TESTMASK >> (k)) & 1) && lo <= (k) && (k) < hi)
#define SEAM(k) do { if (lo <= (k) && (k) + 1 < hi) xcd_barrier(xbar); } while (0)
    if (hi > 1000) grid.sync();

    if (IN(0)) {
        LAS float* scr = (LAS float*)(lds + wave * 16384);
        constexpr int I_GU = (DM / 64) * (NGU / 32), I_D = (DFF / 64) * (DM / 32), I_IN = (DM / 64) * (NIN / 32), I_BR = (1024 / 64) * (DM / 32), I_O = (DM / 64) * (DM / 32);
        constexpr int NITEMS = I_GU + I_D + I_IN;
        for (int it = gw; it < NITEMS; it += ngw) {
            int r = it;
            if (r < I_GU) { transpose_item<1>(a.wgu1, DM, NGU, WGU1, DM, 0, a.n1, scr, r, lane); continue; } r -= I_GU;
            if (r < I_D) { transpose_item<0>(a.wd1, DFF, DM, WD1, DFF, 0, nullptr, scr, r, lane); continue; } r -= I_D;
            transpose_item<2>(a.win, DM, NIN, WIN, DM, 0, a.nmix, scr, r - 0, lane);
        }
        if (!ffn2_deferred)
            for (int it = gw; it < 2 * I_BR + I_O + I_GU + I_D; it += ngw) { int r = it;
                if (r < I_BR) { transpose_item<0>(a.wa, 1024, DM, WAR, 1024, 0, nullptr, scr, r, lane); continue; } r -= I_BR;
                if (r < I_BR) { transpose_item<0>(a.wr, 1024, DM, WAR + (size_t)DM * 1024, 1024, 0, nullptr, scr, r, lane); continue; } r -= I_BR;
                if (r < I_O) { transpose_item<0>(a.wout, DM, DM, WOUT, DM, 0, nullptr, scr, r, lane); continue; } r -= I_O;
                if (r < I_GU) { transpose_item<1>(a.wgu2, DM, NGU, WGU2, DM, 0, a.n2, scr, r, lane); continue; } r -= I_GU;
                transpose_item<0>(a.wd2, DFF, DM, WD2, DFF, 0, nullptr, scr, r, lane); }
        if (!ffn2_deferred)
        for (int idx = bid * NTHREADS + tid; idx < TT * 32; idx += G * NTHREADS) {
            const int tok = idx >> 5, i = idx & 31;
            const float inv_freq = exp2f(-(float)i * 0.41524101186092029f);
            const float ang = (float)a.pos[tok] * inv_freq;
            double rev = (double)ang * 0.15915494309189535; rev -= rint(rev);
            const float fr = (float)rev;
            ROPE[idx] = (f32x2v){__builtin_amdgcn_cosf(fr), __builtin_amdgcn_sinf(fr)};
        }
        for (int m = gw; m < TT; m += ngw) row_to_bf16_ss(a.x + (size_t)m * DM, H + (size_t)m * DM, SS1 + (size_t)m * 8, lane);
    }
    SEAM(0);
    if (IN(1)) { __syncthreads(); pg8::Gemm g{H, WGU1, TT, NGU, DM}; pg8::StaticOrder S; S.init(TT, NGU, G, bid); pg8::EpiSwiglu E{ws, 0};
        pg8::gemm_phase<pg8::EpiSwiglu, pg8::StaticOrder, true, true>(lds, g, S, E); }
    SEAM(1);
    if (IN(2)) { __syncthreads(); pg8::Gemm g{HID, WD1, TT, DM, DFF}; pg8::StaticOrder S; S.init(TT, DM, G, bid); pg8::EpiResidB<0> E{a.out, 0.5f, ws, 1, (LAS float*)(lds + 131072)};
        pg8::gemm_phase<pg8::EpiResidB<0>, pg8::StaticOrder, true, true>(lds, g, S, E); }
    SEAM(2);
    if (IN(4)) { __syncthreads(); pg8::Gemm g{H, WIN, TT, NIN, DM}; pg8::StaticOrder S; S.init(TT, NIN, G, bid); pg8::EpiZ E{ws};
        pg8::gemm_phase<pg8::EpiZ, pg8::StaticOrder, true, true>(lds, g, S, E);
        if (ffn2_deferred && bid >= p4_rem) {
            __syncthreads();
            LAS float* scr = (LAS float*)(lds + wave * 16384);
            constexpr int I_GU = (DM / 64) * (NGU / 32), I_D = (DFF / 64) * (DM / 32), I_BR = (1024 / 64) * (DM / 32), I_O = (DM / 64) * (DM / 32);
            const int gw2 = (bid - p4_rem) * NWAVES + wave, ngw2 = (G - p4_rem) * NWAVES;
            for (int idx = (bid - p4_rem) * NTHREADS + tid; idx < TT * 32; idx += (G - p4_rem) * NTHREADS) {
                const int tok = idx >> 5, i = idx & 31;
                const float inv_freq = exp2f(-(float)i * 0.41524101186092029f);
                const float ang = (float)a.pos[tok] * inv_freq;
                double rev = (double)ang * 0.15915494309189535; rev -= rint(rev);
                const float fr = (float)rev;
                ROPE[idx] = (f32x2v){__builtin_amdgcn_cosf(fr), __builtin_amdgcn_sinf(fr)};
            }
            for (int it = gw2; it < 2 * I_BR + I_O + I_GU + I_D; it += ngw2) { int r = it;
                if (r < I_BR) { transpose_item<0>(a.wa, 1024, DM, WAR, 1024, 0, nullptr, scr, r, lane); continue; } r -= I_BR;
                if (r < I_BR) { transpose_item<0>(a.wr, 1024, DM, WAR + (size_t)DM * 1024, 1024, 0, nullptr, scr, r, lane); continue; } r -= I_BR;
                if (r < I_O) { transpose_item<0>(a.wout, DM, DM, WOUT, DM, 0, nullptr, scr, r, lane); continue; } r -= I_O;
                if (r < I_GU) { transpose_item<1>(a.wgu2, DM, NGU, WGU2, DM, 0, a.n2, scr, r, lane); continue; } r -= I_GU;
                transpose_item<0>(a.wd2, DFF, DM, WD2, DFF, 0, nullptr, scr, r, lane); }
        } }
    SEAM(4);
    if (IN(5)) { __syncthreads();
#ifndef NOHG0
        hgrn_phase<0>(lds, ZH, a.lb, a.hgn, SEGS, SEGD, YR, G, bid, tid);
#endif
#ifndef NOATTN
        attn_phase(lds, ZA, ROPE, a.qn, a.kn, a.sinks, YA, G, bid, tid);
#endif
    }
    SEAM(5);
    if (IN(6)) { __syncthreads(); hgrn_phase<1>(lds, ZH, a.lb, a.hgn, SEGS, SEGD, YR, G, bid, tid); }
    SEAM(6);
    if (IN(7)) { __syncthreads(); pg8::DualOrder S; S.base.init(TT, DM, G, bid);
        pg8::Gemm g{YA, WAR, TT, DM, 1024, YR, WAR + (size_t)DM * 1024}; pg8::EpiMerge E{ws};
        pg8::gemm_phase<pg8::EpiMerge, pg8::DualOrder, true, true>(lds, g, S, E); }
    SEAM(7);
    if (IN(8)) { __syncthreads(); pg8::Gemm g{MRG, WOUT, TT, DM, DM}; pg8::StaticOrder S; S.init(TT, DM, G, bid); pg8::EpiResidB<0> E{a.out, 1.0f, ws, 2, (LAS float*)(lds + 131072)};
        pg8::gemm_phase<pg8::EpiResidB<0>, pg8::StaticOrder, true, true>(lds, g, S, E); }
    SEAM(8);
    if (IN(10)) { __syncthreads(); pg8::Gemm g{H, WGU2, TT, NGU, DM}; pg8::StaticOrder S; S.init(TT, NGU, G, bid); pg8::EpiSwiglu E{ws, 2};
        pg8::gemm_phase<pg8::EpiSwiglu, pg8::StaticOrder, true, true>(lds, g, S, E); }
    SEAM(10);
    if (IN(11)) { __syncthreads(); pg8::Gemm g{HID, WD2, TT, DM, DFF}; pg8::StaticOrder S; S.init(TT, DM, G, bid); pg8::EpiResidB<1> E{a.out, 0.5f, ws, 0, (LAS float*)(lds + 131072)};
        pg8::gemm_phase<pg8::EpiResidB<1>, pg8::StaticOrder, true, true>(lds, g, S, E); }
#undef IN
#undef SEAM
}

#ifndef MK_MULTI
#define MK_MULTI 0
#endif
extern "C" void kernel_launch(void* const* d_in, const int* in_sizes, int n_in, void* d_out, int out_size, void* d_ws, size_t ws_size, hipStream_t stream) {
    static int grid = 0;
    if (grid == 0) {
        if (n_in != 18 || out_size != TT * DM || ws_size < WS_END) { fprintf(stderr, "kernel_launch: unexpected shapes (n_in %d out %d ws %zu)\n", n_in, out_size, ws_size); grid = -1; return; }
        int dev = 0, cus = 0, per_cu = 0;
        (void)hipGetDevice(&dev); (void)hipDeviceGetAttribute(&cus, hipDeviceAttributeMultiprocessorCount, dev);
        (void)hipFuncSetAttribute((const void*)fwd_megakernel, hipFuncAttributeMaxDynamicSharedMemorySize, LDS_BYTES);
        if (hipOccupancyMaxActiveBlocksPerMultiprocessor(&per_cu, (const void*)fwd_megakernel, NTHREADS, LDS_BYTES) != hipSuccess || per_cu < 1) { per_cu = 1; (void)hipGetLastError(); }
        grid = cus * 1;
        if (grid <= 0) grid = 256;
    }
    if (grid < 0) return;
    (void)hipMemsetAsync(d_ws, 0, 16384, stream);
    Args a{};
    a.x = (const float*)d_in[0]; a.pos = (const int*)d_in[1]; a.lb = (const float*)d_in[2]; a.n1 = (const float*)d_in[3]; a.wgu1 = (const float*)d_in[4]; a.wd1 = (const float*)d_in[5];
    a.nmix = (const float*)d_in[6]; a.win = (const float*)d_in[7]; a.qn = (const float*)d_in[8]; a.kn = (const float*)d_in[9]; a.sinks = (const float*)d_in[10]; a.hgn = (const float*)d_in[11];
    a.wa = (const float*)d_in[12]; a.wr = (const float*)d_in[13]; a.wout = (const float*)d_in[14]; a.n2 = (const float*)d_in[15]; a.wgu2 = (const float*)d_in[16]; a.wd2 = (const float*)d_in[17];
    a.out = (float*)d_out; a.ws = (unsigned char*)d_ws;
#if MK_MULTI
    for (int p = 0; p < 12; ++p) { a.ph_lo = p; a.ph_hi = p + 1; hipLaunchKernelGGL(fwd_megakernel, dim3(grid), dim3(NTHREADS), LDS_BYTES, stream, a); }
#else
    a.ph_lo = 0; a.ph_hi = 12;
    void* args[] = {&a};
    hipError_t e = hipLaunchCooperativeKernel((const void*)fwd_megakernel, dim3(grid), dim3(NTHREADS), args, LDS_BYTES, stream);
    if (e != hipSuccess) fprintf(stderr, "cooperative launch failed: %s (grid %d)\n", hipGetErrorString(e), grid);
#endif
}
```

```cpp
#include <hip/hip_runtime.h>
#include <hip/hip_cooperative_groups.h>
#include <cstdio>
#include <cstdint>
namespace cg = cooperative_groups;
constexpr int BATCH = 2, SEQ = 16384, DM = 2048, TT = BATCH * SEQ, DFF = 5632, NGU = 2 * DFF, NIN = 9472;
constexpr int NTHREADS = 512, NWAVES = 8;
constexpr int LDS_BYTES = 147456;
constexpr size_t MiB = 1u << 20;
constexpr size_t WS_WGU1 = 1 * MiB, WS_WD1 = 45 * MiB, WS_WIN = 67 * MiB, WS_WAR = 104 * MiB, WS_WOUT = 112 * MiB, WS_WGU2 = 120 * MiB, WS_WD2 = 164 * MiB;
constexpr size_t WS_ROPE = 186 * MiB, WS_SEGS = 194 * MiB, WS_SEGD = 210 * MiB, WS_H = 212 * MiB, WS_ZA = 340 * MiB, WS_ZH = 420 * MiB, WS_ZG = 676 * MiB, WS_SS = 932 * MiB, WS_END = 936 * MiB;
constexpr size_t WS_HID = WS_ZA, WS_MRG = WS_ZH;

namespace pg8 {
#define PG8_LAS __attribute__((address_space(3)))
typedef unsigned short bf16_t;
typedef short bf16x8 __attribute__((ext_vector_type(8)));
typedef float f32x4 __attribute__((ext_vector_type(4)));
typedef unsigned u32x4 __attribute__((ext_vector_type(4)));
constexpr int BM = 256, BK = 64, HALF = 128, HTB = HALF * BK * 2  , STAGE_BYTES = 8 * HTB, NXCD = 8, WGM = 8;

__host__ __device__ __forceinline__ int lds_byte(int r, int c) { const int st = (r >> 4) * 2 + (c >> 5), rr = r & 15, cc = c & 31, ob = rr * 64 + cc * 2; return st * 1024 + (ob ^ (((ob >> 9) & 1) << 5)); }
__host__ __device__ __forceinline__ void stage_rc(int b, int& R, int& C) { const int st = b / 1024, sb = b % 1024, swz = sb ^ (((sb >> 9) & 1) << 5); R = (st >> 1) * 16 + swz / 64; C = (st & 1) * 32 + (swz % 64) / 2; }
__host__ __device__ __forceinline__ int perm32(int rho) { const int n = rho >> 4, i = rho & 15; return 8 * (i >> 2) + 4 * n + (i & 3); }

struct Unit { int pm, pn, half; };
struct Gemm { const bf16_t* A; const bf16_t* Bt; int M, N, K; const bf16_t* A2; const bf16_t* B2; };

struct StaticOrder {
    int nM, nN, nwg, G, c;
    __host__ __device__ void init(int M, int N, int G_, int c_) { nM = M / BM; nN = N / BM; nwg = nM * nN; G = G_; c = c_; }
    __host__ __device__ bool next(int i, Unit& u) const {
        const long L = (long)i * G + c; if (L >= nwg) return false;
        int wgid = (int)L; { const int q = nwg / NXCD, r = nwg % NXCD, xcd = wgid % NXCD, off = wgid / NXCD; wgid = (xcd < r ? xcd * (q + 1) : r * (q + 1) + (xcd - r) * q) + off; }
        const int nig = WGM * nN, gid = wgid / nig, fm = gid * WGM, gsz = (nM - fm) < WGM ? (nM - fm) : WGM;
        u.pm = fm + ((wgid % nig) % gsz); u.pn = (wgid % nig) / gsz; u.half = 0; return true;
    }
    __device__ __forceinline__ void a_ready(const Unit&) const {}
    __device__ __forceinline__ void done(const Unit&) const {}
};
struct DualOrder {
    StaticOrder base;
    __host__ __device__ bool next(int i, Unit& u) const { if (!base.next(i >> 1, u)) return false; u.half = i & 1; return true; }
    __device__ __forceinline__ void a_ready(const Unit&) const {}
    __device__ __forceinline__ void done(const Unit&) const {}
};
__device__ __forceinline__ unsigned cvt_pk_bf16(float lo, float hi) { unsigned r; asm volatile("v_cvt_pk_bf16_f32 %0, %1, %2" : "=v"(r) : "v"(lo), "v"(hi)); return r; }
typedef float f32x2 __attribute__((ext_vector_type(2)));
__device__ __forceinline__ float fast_exp(float x) { return __builtin_amdgcn_exp2f(x * 1.4426950408889634f); }
__device__ __forceinline__ float fast_log(float x) { return __builtin_amdgcn_logf(x) * 0.6931471805599453f; }
__device__ __forceinline__ float fast_sigmoid(float x) { return __builtin_amdgcn_rcpf(1.0f + fast_exp(-x)); }
__device__ __forceinline__ float fast_silu(float x) { return x * fast_sigmoid(x); }
__device__ __forceinline__ float bf_lo(unsigned w) { return __uint_as_float(w << 16); }
__device__ __forceinline__ float bf_hi(unsigned w) { return __uint_as_float(w & 0xffff0000u); }

struct EpiSwiglu {
    static constexpr bool PERM = true, AFTER_DRAIN = false, MIDHOOK = false, DUAL = false;
    unsigned char* ws; int ssidx;
    __device__ __forceinline__ void operator()(const f32x4 (&acc)[2][2][4][2], const Unit& u, int wr, int wc, int fr, int fq) const {
        const int row0 = u.pm * BM + wr * 64 + fr; const int col0 = u.pn * HALF + wc * 32 + 8 * fq;
        bf16_t* O = (bf16_t*)(ws + WS_HID); const float* SS = (const float*)(ws + WS_SS) + (size_t)ssidx * TT * 8; constexpr int ldc = DFF;
        float rsv[2][4];
        { f32x4 sa[2][4], sb[2][4];
#pragma unroll
          for (int ai = 0; ai < 2; ++ai)
#pragma unroll
              for (int m = 0; m < 4; ++m) { const size_t row = (size_t)(row0 + ai * HALF + m * 16); sa[ai][m] = *(const f32x4*)(SS + row * 8); sb[ai][m] = *(const f32x4*)(SS + row * 8 + 4); }
          asm volatile("" ::: "memory");
#pragma unroll
          for (int ai = 0; ai < 2; ++ai)
#pragma unroll
              for (int m = 0; m < 4; ++m) rsv[ai][m] = rsqrtf((((sa[ai][m][0] + sa[ai][m][1]) + (sa[ai][m][2] + sa[ai][m][3])) + ((sb[ai][m][0] + sb[ai][m][1]) + (sb[ai][m][2] + sb[ai][m][3]))) * (1.0f / 2048.0f) + 1e-6f); }
#pragma unroll
        for (int ai = 0; ai < 2; ++ai)
#pragma unroll
            for (int m = 0; m < 4; ++m) { const int row = row0 + ai * HALF + m * 16; bf16_t* p = O + (size_t)row * ldc + col0;
                const float rs = rsv[ai][m];
                const f32x4 g0 = acc[ai][0][m][0] * rs, g1 = acc[ai][0][m][1] * rs, u0 = acc[ai][1][m][0] * rs, u1 = acc[ai][1][m][1] * rs;
                u32x4 w; w.x = cvt_pk_bf16(fast_silu(g0[0]) * u0[0], fast_silu(g0[1]) * u0[1]); w.y = cvt_pk_bf16(fast_silu(g0[2]) * u0[2], fast_silu(g0[3]) * u0[3]);
                w.z = cvt_pk_bf16(fast_silu(g1[0]) * u1[0], fast_silu(g1[1]) * u1[1]); w.w = cvt_pk_bf16(fast_silu(g1[2]) * u1[2], fast_silu(g1[3]) * u1[3]);
                *(u32x4*)p = w; }
    }
};
typedef unsigned u32x2e __attribute__((ext_vector_type(2)));
template <bool STATS> struct EpiResid {
    static constexpr bool PERM = false, AFTER_DRAIN = false, MIDHOOK = false, DUAL = false;
    const float* base; float* out; float scale; unsigned char* ws; int ssidx;
    __device__ __forceinline__ void operator()(const f32x4 (&acc)[2][2][4][2], const Unit& u, int wr, int wc, int fr, int fq) const {
        const int row0 = u.pm * BM + wr * 64 + fr; const int col0 = u.pn * BM + wc * 32 + 4 * fq;
        bf16_t* XB = (bf16_t*)(ws + WS_H); float* SSn = (float*)(ws + WS_SS) + (size_t)ssidx * TT; constexpr int ldc = DM;
#pragma unroll
        for (int ai = 0; ai < 2; ++ai) {
            f32x4 bv[4][2][2];
#pragma unroll
            for (int m = 0; m < 4; ++m) { const size_t off = (size_t)(row0 + ai * HALF + m * 16) * ldc + col0;
#pragma unroll
                for (int bj = 0; bj < 2; ++bj)
#pragma unroll
                    for (int n = 0; n < 2; ++n) bv[m][bj][n] = *(const f32x4*)(base + off + bj * HALF + n * 16); }
            asm volatile("" ::: "memory");
#pragma unroll
            for (int m = 0; m < 4; ++m) { const int row = row0 + ai * HALF + m * 16; const size_t off = (size_t)row * ldc + col0; float part = 0.f;
#pragma unroll
                for (int bj = 0; bj < 2; ++bj)
#pragma unroll
                    for (int n = 0; n < 2; ++n) { const f32x4 v = bv[m][bj][n] + acc[ai][bj][m][n] * scale; *(f32x4*)(out + off + bj * HALF + n * 16) = v;
                        if (STATS) { u32x2e w; w.x = cvt_pk_bf16(v[0], v[1]); w.y = cvt_pk_bf16(v[2], v[3]); *(u32x2e*)(XB + off + bj * HALF + n * 16) = w; part += (v[0] * v[0] + v[1] * v[1]) + (v[2] * v[2] + v[3] * v[3]); } }
                if (STATS) { part += __shfl_xor(part, 16); part += __shfl_xor(part, 32); if (fq == 0) __hip_atomic_fetch_add(SSn + row, part, __ATOMIC_RELAXED, __HIP_MEMORY_SCOPE_AGENT); } }
        }
    }
};
template <int MODE> struct EpiResidB {
    static constexpr bool PERM = true, AFTER_DRAIN = false, MIDHOOK = false, DUAL = false;
    float* out; float scale; unsigned char* ws; int ssidx; PG8_LAS float* P;
    __device__ __forceinline__ void operator()(const f32x4 (&acc)[2][2][4][2], const Unit& u, int wr, int wc, int fr, int fq) const {
        const int row0 = u.pm * BM + wr * 64 + fr; const int col0 = u.pn * BM + wc * 32 + 8 * fq;
        bf16_t* XB = (bf16_t*)(ws + WS_H); float* SSn = (float*)(ws + WS_SS) + (size_t)ssidx * TT * 8; constexpr int ldc = DM;
#pragma unroll
        for (int ai = 0; ai < 2; ++ai) {
            u32x4 bv[4][2];
#pragma unroll
            for (int m = 0; m < 4; ++m) { const size_t off = (size_t)(row0 + ai * HALF + m * 16) * ldc + col0;
#pragma unroll
                for (int bj = 0; bj < 2; ++bj) bv[m][bj] = *(const u32x4*)(XB + off + bj * HALF); }
            asm volatile("" ::: "memory");
#pragma unroll
            for (int m = 0; m < 4; ++m) { const int row = row0 + ai * HALF + m * 16; const size_t off = (size_t)row * ldc + col0; float part = 0.f;
#pragma unroll
                for (int bj = 0; bj < 2; ++bj) { const u32x4 b = bv[m][bj];
                    const f32x4 v0 = (f32x4){bf_lo(b.x), bf_hi(b.x), bf_lo(b.y), bf_hi(b.y)} + acc[ai][bj][m][0] * scale, v1 = (f32x4){bf_lo(b.z), bf_hi(b.z), bf_lo(b.w), bf_hi(b.w)} + acc[ai][bj][m][1] * scale;
                    if (MODE == 0) {
                        u32x4 w; w.x = cvt_pk_bf16(v0[0], v0[1]); w.y = cvt_pk_bf16(v0[2], v0[3]); w.z = cvt_pk_bf16(v1[0], v1[1]); w.w = cvt_pk_bf16(v1[2], v1[3]);
                        *(u32x4*)(XB + off + bj * HALF) = w;
                        const float r0 = bf_lo(w.x), r1 = bf_hi(w.x), r2 = bf_lo(w.y), r3 = bf_hi(w.y), r4 = bf_lo(w.z), r5 = bf_hi(w.z), r6 = bf_lo(w.w), r7 = bf_hi(w.w);
                        part += ((r0 * r0 + r1 * r1) + (r2 * r2 + r3 * r3)) + ((r4 * r4 + r5 * r5) + (r6 * r6 + r7 * r7));
                    } else { *(f32x4*)(out + off + bj * HALF) = v0; *(f32x4*)(out + off + bj * HALF + 4) = v1; } }
                if (MODE == 0) { part += __shfl_xor(part, 16); part += __shfl_xor(part, 32); if (fq == 0) P[(ai * HALF + wr * 64 + m * 16 + fr) * 4 + wc] = part; } }
        }
        if (MODE == 0) {
            asm volatile("s_waitcnt lgkmcnt(0)" ::: "memory"); __builtin_amdgcn_s_barrier(); asm volatile("" ::: "memory");
            if (wr == 0) { const int rt = wc * 64 + fq * 16 + fr; const f32x4 pv = *(const PG8_LAS f32x4*)(P + rt * 4); SSn[(size_t)(u.pm * BM + rt) * 8 + u.pn] = (pv[0] + pv[1]) + (pv[2] + pv[3]); }
        }
    }
};
struct EpiZ {
    static constexpr bool PERM = true, AFTER_DRAIN = false, MIDHOOK = false, DUAL = false;
    unsigned char* ws;
    __device__ __forceinline__ void operator()(const f32x4 (&acc)[2][2][4][2], const Unit& u, int wr, int wc, int fr, int fq) const {
        bf16_t* ZA = (bf16_t*)(ws + WS_ZA); bf16_t* ZH = (bf16_t*)(ws + WS_ZH); bf16_t* ZG = (bf16_t*)(ws + WS_ZG); const float* SS = (const float*)(ws + WS_SS) + (size_t)TT * 8;
        const int row0 = u.pm * BM + wr * 64 + fr;
        float rsv[2][4];
        { f32x4 sa[2][4], sb[2][4];
#pragma unroll
          for (int ai = 0; ai < 2; ++ai)
#pragma unroll
              for (int m = 0; m < 4; ++m) { const size_t row = (size_t)(row0 + ai * HALF + m * 16); sa[ai][m] = *(const f32x4*)(SS + row * 8); sb[ai][m] = *(const f32x4*)(SS + row * 8 + 4); }
          asm volatile("" ::: "memory");
#pragma unroll
          for (int ai = 0; ai < 2; ++ai)
#pragma unroll
              for (int m = 0; m < 4; ++m) rsv[ai][m] = rsqrtf((((sa[ai][m][0] + sa[ai][m][1]) + (sa[ai][m][2] + sa[ai][m][3])) + ((sb[ai][m][0] + sb[ai][m][1]) + (sb[ai][m][2] + sb[ai][m][3]))) * (1.0f / 2048.0f) + 1e-6f); }
        if (u.pn < 21) {
            bf16_t* basep; int ld, colt;
            if (u.pn < 5) { basep = ZA; ld = 1280; colt = u.pn * BM; } else { basep = ZH; ld = 4096; colt = (u.pn - 5) * BM; }
            const int col0 = colt + wc * 32 + 8 * fq;
#pragma unroll
            for (int ai = 0; ai < 2; ++ai)
#pragma unroll
                for (int m = 0; m < 4; ++m) { const int row = row0 + ai * HALF + m * 16; bf16_t* rowp = basep + (size_t)row * ld + col0;
                    const float rs = rsv[ai][m];
#pragma unroll
                    for (int bj = 0; bj < 2; ++bj) { const f32x4 v0 = acc[ai][bj][m][0] * rs, v1 = acc[ai][bj][m][1] * rs;
                        u32x4 w; w.x = cvt_pk_bf16(v0[0], v0[1]); w.y = cvt_pk_bf16(v0[2], v0[3]); w.z = cvt_pk_bf16(v1[0], v1[1]); w.w = cvt_pk_bf16(v1[2], v1[3]);
                        *(u32x4*)(rowp + bj * HALF) = w; } }
        } else {
            const int col0 = (u.pn - 21) * HALF + wc * 32 + 8 * fq;
#pragma unroll
            for (int ai = 0; ai < 2; ++ai)
#pragma unroll
                for (int m = 0; m < 4; ++m) { const int row = row0 + ai * HALF + m * 16; bf16_t* rowp = ZG + (size_t)row * 4096 + col0;
                    const float rs = rsv[ai][m];
                    float rt[8], gr[8];
#pragma unroll
                    for (int n = 0; n < 2; ++n)
#pragma unroll
                        for (int k = 0; k < 4; ++k) { const float a = acc[ai][0][m][n][k] * rs, b = fmaxf(acc[ai][1][m][n][k] * rs, -60.0f);
                            const float ea = 1.0f + fast_exp(-a), eb = 1.0f + fast_exp(-b); gr[4 * n + k] = __builtin_amdgcn_rcpf(eb); rt[4 * n + k] = eb * __builtin_amdgcn_rcpf(ea); }
                    u32x4 w; w.x = cvt_pk_bf16(rt[0], rt[1]); w.y = cvt_pk_bf16(rt[2], rt[3]); w.z = cvt_pk_bf16(rt[4], rt[5]); w.w = cvt_pk_bf16(rt[6], rt[7]); *(u32x4*)rowp = w;
                    u32x4 g; g.x = cvt_pk_bf16(gr[0], gr[1]); g.y = cvt_pk_bf16(gr[2], gr[3]); g.z = cvt_pk_bf16(gr[4], gr[5]); g.w = cvt_pk_bf16(gr[6], gr[7]); *(u32x4*)(rowp + 2048) = g; }
        }
    }
};
struct EpiMerge {
    static constexpr bool PERM = true, AFTER_DRAIN = false, MIDHOOK = false, DUAL = true;
    unsigned char* ws;
    __device__ __forceinline__ void mid(f32x4 (&acc)[2][2][4][2], const Unit& u, int wr, int wc, int fr, int fq) const {
        const int row0 = u.pm * BM + wr * 64 + fr; const int col0 = u.pn * BM + wc * 32 + 8 * fq;
        const bf16_t* ZG = (const bf16_t*)(ws + WS_ZG);
#pragma unroll
        for (int ai = 0; ai < 2; ++ai) {
            u32x4 gw[4][2];
#pragma unroll
            for (int m = 0; m < 4; ++m) { const size_t r = (size_t)(row0 + ai * HALF + m * 16);
#pragma unroll
                for (int bj = 0; bj < 2; ++bj) gw[m][bj] = *(const u32x4*)(ZG + r * 4096 + col0 + bj * HALF); }
            asm volatile("" ::: "memory");
#pragma unroll
            for (int m = 0; m < 4; ++m)
#pragma unroll
                for (int bj = 0; bj < 2; ++bj) { const u32x4 w = gw[m][bj];
                    acc[ai][bj][m][0] = acc[ai][bj][m][0] * (f32x4){bf_lo(w.x), bf_hi(w.x), bf_lo(w.y), bf_hi(w.y)}; acc[ai][bj][m][1] = acc[ai][bj][m][1] * (f32x4){bf_lo(w.z), bf_hi(w.z), bf_lo(w.w), bf_hi(w.w)}; }
        }
    }
    __device__ __forceinline__ void operator()(const f32x4 (&acc)[2][2][4][2], const Unit& u, int wr, int wc, int fr, int fq) const {
        const int row0 = u.pm * BM + wr * 64 + fr; const int col0 = u.pn * BM + wc * 32 + 8 * fq;
        const bf16_t* ZG = (const bf16_t*)(ws + WS_ZG); bf16_t* O = (bf16_t*)(ws + WS_MRG);
#pragma unroll
        for (int ai = 0; ai < 2; ++ai) {
            u32x4 gw[4][2];
#pragma unroll
            for (int m = 0; m < 4; ++m) { const size_t r = (size_t)(row0 + ai * HALF + m * 16);
#pragma unroll
                for (int bj = 0; bj < 2; ++bj) gw[m][bj] = *(const u32x4*)(ZG + r * 4096 + 2048 + col0 + bj * HALF); }
            asm volatile("" ::: "memory");
#pragma unroll
            for (int m = 0; m < 4; ++m) { const size_t r = (size_t)(row0 + ai * HALF + m * 16);
#pragma unroll
                for (int bj = 0; bj < 2; ++bj) { const u32x4 g = gw[m][bj];
                    const f32x4 v0 = acc[ai][bj][m][0] * (f32x4){bf_lo(g.x), bf_hi(g.x), bf_lo(g.y), bf_hi(g.y)}, v1 = acc[ai][bj][m][1] * (f32x4){bf_lo(g.z), bf_hi(g.z), bf_lo(g.w), bf_hi(g.w)};
                    u32x4 w; w.x = cvt_pk_bf16(v0[0], v0[1]); w.y = cvt_pk_bf16(v0[2], v0[3]); w.z = cvt_pk_bf16(v1[0], v1[1]); w.w = cvt_pk_bf16(v1[2], v1[3]);
                    *(u32x4*)(O + r * 2048 + col0 + bj * HALF) = w; } }
        }
    }
};
template <class Epi, class Sched, bool ALIGN_EPI = false, bool SP2 = false>
__device__ __forceinline__ void gemm_phase(PG8_LAS unsigned char* lds, const Gemm g, const Sched& S, const Epi& E) {
    const int tid = threadIdx.x, wid = __builtin_amdgcn_readfirstlane(tid >> 6), lane = tid & 63, wr = wid >> 2, wc = wid & 3, fr = lane & 15, fq = lane >> 4;
    const int K = g.K, nt = K / BK;
    unsigned voffA[2], voffB[2];
#pragma unroll
    for (int i = 0; i < 2; ++i) { int R, C; stage_rc(tid * 16 + i * 8192, R, C); const int Rb = Epi::PERM ? ((R & ~31) + perm32(R & 31)) : R;
        voffA[i] = (unsigned)(R * K + C) * 2u; voffB[i] = (unsigned)(Rb * K + C) * 2u; }
    const size_t kstep = (size_t)(BK * 2);
    const size_t hstep = (size_t)HALF * K * 2;
    const size_t tstep = 2 * hstep;
    const unsigned ldsw = (unsigned)wid * 1024u;
    const int aoff = lds_byte(wr * 64 + fr, fq * 8), boff = lds_byte(wc * 32 + fr, fq * 8);
#define PG8_SA(b, h) (((b) * 2 + (h)) * HTB)
#define PG8_SB(b, h) ((4 + (b) * 2 + (h)) * HTB)
#define PG8_STAGE(bufoff, gbase, voff) do { _Pragma("unroll") for (int _i = 0; _i < 2; ++_i) \
        __builtin_amdgcn_global_load_lds((const unsigned*)((const char*)(gbase) + (voff)[_i]), (PG8_LAS unsigned*)(lds + (bufoff) + ldsw + _i * 8192), 16, 0, 0); } while (0)
#define PG8_LDA(dst, b, h) do { _Pragma("unroll") for (int m = 0; m < 4; ++m) _Pragma("unroll") for (int k = 0; k < 2; ++k) dst[m][k] = *(const PG8_LAS bf16x8*)(lds + PG8_SA(b, h) + aoff + m * 2048 + k * 1024); } while (0)
#define PG8_LDB(dst, b, h) do { _Pragma("unroll") for (int n = 0; n < 2; ++n) _Pragma("unroll") for (int k = 0; k < 2; ++k) dst[n][k] = *(const PG8_LAS bf16x8*)(lds + PG8_SB(b, h) + boff + n * 2048 + k * 1024); } while (0)
#define PG8_MMA(ai, bj, At, Bt) do { __builtin_amdgcn_s_setprio(1); _Pragma("unroll") for (int m = 0; m < 4; ++m) _Pragma("unroll") for (int n = 0; n < 2; ++n) _Pragma("unroll") for (int k = 0; k < 2; ++k) \
        acc[ai][bj][m][n] = __builtin_amdgcn_mfma_f32_16x16x32_bf16(Bt[n][k], At[m][k], acc[ai][bj][m][n], 0, 0, 0); __builtin_amdgcn_s_setprio(0); } while (0)
#define PG8_WAIT_V(n) asm volatile("s_waitcnt vmcnt(" #n ")" ::: "memory")
#define PG8_WAIT_L(n) asm volatile("s_waitcnt lgkmcnt(" #n ")" ::: "memory")
#define PG8_BAR __builtin_amdgcn_s_barrier()
#define PG8_SCHED __builtin_amdgcn_sched_barrier(0)
    Unit cur, nxt; int ui = 0;
    if (!S.next(0, cur)) return;
    f32x4 acc[2][2][4][2];
#pragma unroll
    for (int a = 0; a < 2; ++a)
#pragma unroll
        for (int b = 0; b < 2; ++b)
#pragma unroll
            for (int m = 0; m < 4; ++m)
#pragma unroll
                for (int n = 0; n < 2; ++n) acc[a][b][m][n] = (f32x4){0.f, 0.f, 0.f, 0.f};
    bf16x8 At[4][2], B0[2][2], B1[2][2];
    const char* cA = (const char*)((Epi::DUAL && cur.half) ? g.A2 : g.A) + (size_t)cur.pm * tstep; const char* cB = (const char*)((Epi::DUAL && cur.half) ? g.B2 : g.Bt) + (size_t)cur.pn * tstep;
    S.a_ready(cur);
    if constexpr (SP2) {
        PG8_STAGE(PG8_SB(0, 0), cB, voffB); PG8_STAGE(PG8_SB(0, 1), cB + hstep, voffB); PG8_STAGE(PG8_SA(0, 0), cA, voffA); PG8_STAGE(PG8_SA(0, 1), cA + hstep, voffA);
        if (wr == 1) PG8_BAR;
        PG8_WAIT_V(2); PG8_BAR;
        PG8_STAGE(PG8_SB(1, 0), cB + kstep, voffB); PG8_STAGE(PG8_SA(1, 0), cA + kstep, voffA); PG8_STAGE(PG8_SB(1, 1), cB + hstep + kstep, voffB);
        PG8_WAIT_V(6); PG8_BAR;
    } else {
        PG8_STAGE(PG8_SB(0, 0), cB, voffB); PG8_STAGE(PG8_SA(0, 0), cA, voffA); PG8_STAGE(PG8_SB(0, 1), cB + hstep, voffB); PG8_STAGE(PG8_SA(0, 1), cA + hstep, voffA);
        if (wr == 1) PG8_BAR;
        PG8_WAIT_V(4); PG8_BAR;
        PG8_STAGE(PG8_SB(1, 0), cB + kstep, voffB); PG8_STAGE(PG8_SA(1, 0), cA + kstep, voffA); PG8_STAGE(PG8_SB(1, 1), cB + hstep + kstep, voffB);
        PG8_WAIT_V(6); PG8_BAR;
    }
    for (;;) {
        const bool has_next = S.next(ui + 1, nxt);
        const char* nA = has_next ? (const char*)((Epi::DUAL && nxt.half) ? g.A2 : g.A) + (size_t)nxt.pm * tstep : cA; const char* nB = has_next ? (const char*)((Epi::DUAL && nxt.half) ? g.B2 : g.Bt) + (size_t)nxt.pn * tstep : cB;
        for (int t = 0; t < nt; t += 2) {
            const bool last = (t == nt - 2);
            const char* a1 = cA + (size_t)(t + 1) * kstep;
            const char* a2 = last ? nA : cA + (size_t)(t + 2) * kstep; const char* b2 = last ? nB : cB + (size_t)(t + 2) * kstep;
            const char* a3 = a2 + kstep; const char* b3 = b2 + kstep;
            if (last && has_next) S.a_ready(nxt);
            if constexpr (SP2) {
            PG8_LDB(B0, 0, 0); PG8_LDB(B1, 0, 1); PG8_SCHED; PG8_LDA(At, 0, 0); PG8_STAGE(PG8_SA(1, 1), a1 + hstep, voffA);
            PG8_WAIT_V(8); PG8_WAIT_L(0); PG8_BAR; PG8_MMA(0, 0, At, B0); PG8_MMA(0, 1, At, B1); PG8_BAR; PG8_SCHED;
            PG8_LDA(At, 0, 1); PG8_STAGE(PG8_SB(0, 0), b2, voffB); PG8_STAGE(PG8_SB(0, 1), b2 + hstep, voffB); PG8_STAGE(PG8_SA(0, 0), a2, voffA);
            PG8_WAIT_V(8); PG8_WAIT_L(0); PG8_BAR; PG8_MMA(1, 0, At, B0); PG8_MMA(1, 1, At, B1); PG8_BAR; PG8_SCHED;
            PG8_LDB(B0, 1, 0); PG8_LDB(B1, 1, 1); PG8_SCHED; PG8_LDA(At, 1, 0); PG8_STAGE(PG8_SA(0, 1), a2 + hstep, voffA);
            PG8_WAIT_V(8); PG8_WAIT_L(0); PG8_BAR; PG8_MMA(0, 0, At, B0); PG8_MMA(0, 1, At, B1); PG8_BAR; PG8_SCHED;
            PG8_LDA(At, 1, 1); PG8_STAGE(PG8_SB(1, 0), b3, voffB); PG8_STAGE(PG8_SB(1, 1), b3 + hstep, voffB); PG8_STAGE(PG8_SA(1, 0), a3, voffA);
            PG8_WAIT_V(8); PG8_WAIT_L(0); PG8_BAR; PG8_MMA(1, 0, At, B0); PG8_MMA(1, 1, At, B1); PG8_BAR; PG8_SCHED;
            } else {
            PG8_LDB(B0, 0, 0); PG8_SCHED; PG8_LDA(At, 0, 0); PG8_STAGE(PG8_SA(1, 1), a1 + hstep, voffA);
            PG8_WAIT_L(8); PG8_BAR; PG8_WAIT_L(0); PG8_MMA(0, 0, At, B0); PG8_BAR; PG8_SCHED;
            PG8_LDB(B1, 0, 1); PG8_STAGE(PG8_SB(0, 0), b2, voffB);
            PG8_BAR; PG8_WAIT_L(0); PG8_MMA(0, 1, At, B1); PG8_BAR;
            PG8_LDA(At, 0, 1); PG8_STAGE(PG8_SA(0, 0), a2, voffA);
            PG8_BAR; PG8_WAIT_L(0); PG8_MMA(1, 0, At, B0); PG8_BAR; PG8_SCHED;
            PG8_STAGE(PG8_SB(0, 1), b2 + hstep, voffB);
            PG8_WAIT_V(6); PG8_BAR; PG8_MMA(1, 1, At, B1); PG8_BAR;
            PG8_LDB(B0, 1, 0); PG8_SCHED; PG8_LDA(At, 1, 0); PG8_STAGE(PG8_SA(0, 1), a2 + hstep, voffA);
            PG8_WAIT_L(8); PG8_BAR; PG8_WAIT_L(0); PG8_MMA(0, 0, At, B0); PG8_BAR; PG8_SCHED;
            PG8_LDB(B1, 1, 1); PG8_STAGE(PG8_SB(1, 0), b3, voffB);
            PG8_BAR; PG8_WAIT_L(0); PG8_MMA(0, 1, At, B1); PG8_BAR;
            PG8_LDA(At, 1, 1); PG8_STAGE(PG8_SA(1, 0), a3, voffA);
            PG8_BAR; PG8_WAIT_L(0); PG8_MMA(1, 0, At, B0); PG8_BAR; PG8_SCHED;
            PG8_STAGE(PG8_SB(1, 1), b3 + hstep, voffB);
            PG8_WAIT_V(6); PG8_BAR; PG8_MMA(1, 1, At, B1); PG8_BAR;
            }
        }
        if constexpr (ALIGN_EPI) { if (wr == 0) PG8_BAR; }
        const bool first_half = Epi::DUAL && cur.half == 0;
        if constexpr (Epi::DUAL) { if (first_half) E.mid(acc, cur, wr, wc, fr, fq); else E(acc, cur, wr, wc, fr, fq); }
        else if constexpr (!Epi::AFTER_DRAIN) { E(acc, cur, wr, wc, fr, fq); S.done(cur); }
        if (!has_next) break;
        if (!first_half)
#pragma unroll
        for (int a = 0; a < 2; ++a)
#pragma unroll
            for (int b = 0; b < 2; ++b)
#pragma unroll
                for (int m = 0; m < 4; ++m)
#pragma unroll
                    for (int n = 0; n < 2; ++n) acc[a][b][m][n] = (f32x4){0.f, 0.f, 0.f, 0.f};
        cur = nxt; cA = nA; cB = nB; ++ui;
        if constexpr (ALIGN_EPI) { if (wr == 1) PG8_BAR; }
    }
    PG8_WAIT_V(0);
    if constexpr (!ALIGN_EPI) { if (wr == 0) PG8_BAR; }
    PG8_BAR;
    if constexpr (Epi::AFTER_DRAIN) { E.fused(acc, cur, wr, wc, fr, fq, lds, wid, lane); S.done(cur); }
#undef PG8_SA
#undef PG8_SB
#undef PG8_STAGE
#undef PG8_LDA
#undef PG8_LDB
#undef PG8_MMA
#undef PG8_WAIT_V
#undef PG8_WAIT_L
#undef PG8_BAR
#undef PG8_SCHED
}
}

using pg8::bf16_t; using pg8::f32x4; using pg8::u32x4; using pg8::cvt_pk_bf16; using pg8::bf_lo; using pg8::bf_hi; using pg8::fast_sigmoid; using pg8::fast_silu; using pg8::fast_exp; using pg8::fast_log;
#define LAS __attribute__((address_space(3)))
typedef unsigned u32x2 __attribute__((ext_vector_type(2)));
typedef float f32x2v __attribute__((ext_vector_type(2)));
struct Args {
    const float* x; const int* pos; const float* lb; const float* n1; const float* wgu1; const float* wd1; const float* nmix; const float* win; const float* qn; const float* kn;
    const float* sinks; const float* hgn; const float* wa; const float* wr; const float* wout; const float* n2; const float* wgu2; const float* wd2; float* out; unsigned char* ws; int ph_lo, ph_hi;
};

__device__ __forceinline__ float wave_sum(float v) {
#pragma unroll
    for (int o = 1; o < 64; o <<= 1) v += __shfl_xor(v, o);
    return v;
}
template <int MODE, bool NT = false> __device__ __forceinline__ void transpose_item(const float* W, int K, int N, bf16_t* WT, int ldk, int koff, const float* gain, LAS float* scr, int item, int lane) {
    const int nblk = N / 32, kb = item / nblk, nb = item % nblk, k0 = 64 * kb, n0 = 32 * nb;
    float v[32];
#pragma unroll
    for (int i = 0; i < 32; ++i) { const int kk = 2 * i + (lane >> 5); v[i] = __builtin_nontemporal_load(W + (size_t)(k0 + kk) * N + n0 + (lane & 31)); }
    if (gain) {
#pragma unroll
        for (int i = 0; i < 32; ++i) v[i] *= gain[k0 + 2 * i + (lane >> 5)]; }
#pragma unroll
    for (int i = 0; i < 32; ++i) { const int kk = 2 * i + (lane >> 5); scr[kk * 33 + (lane & 31)] = v[i]; }
    asm volatile("s_waitcnt lgkmcnt(0)" ::: "memory");
    int r0 = n0;
    if (MODE == 1) { const int j = n0 < DFF ? n0 : n0 - DFF; r0 = 256 * (j >> 7) + (j & 127) + (n0 < DFF ? 0 : 128); }
    if (MODE == 2 && n0 >= 5376) { const int q = n0 - 5376, br = q >> 11, c = q & 2047; r0 = 5376 + 256 * (c >> 7) + 128 * br + (c & 127); }
    const int c = lane & 7;
#pragma unroll
    for (int j = 0; j < 4; ++j) { const int n = (lane >> 3) + 8 * j; const LAS float* s = scr + (8 * c) * 33 + n;
        u32x4 o; o.x = cvt_pk_bf16(s[0 * 33], s[1 * 33]); o.y = cvt_pk_bf16(s[2 * 33], s[3 * 33]); o.z = cvt_pk_bf16(s[4 * 33], s[5 * 33]); o.w = cvt_pk_bf16(s[6 * 33], s[7 * 33]);
        if (NT) __builtin_nontemporal_store(o, (u32x4*)(WT + (size_t)(r0 + n) * ldk + koff + k0 + 8 * c)); else *(u32x4*)(WT + (size_t)(r0 + n) * ldk + koff + k0 + 8 * c) = o; }
    asm volatile("s_waitcnt lgkmcnt(0)" ::: "memory");
}
__device__ __forceinline__ void row_to_bf16_ss(const float* xrow, bf16_t* orow, float* ss, int lane) {
    const f32x4* xr = (const f32x4*)xrow + lane;
    f32x4 v[8]; float s = 0.f;
#pragma unroll
    for (int j = 0; j < 8; ++j) { v[j] = __builtin_nontemporal_load(xr + 64 * j); s += (v[j].x * v[j].x + v[j].y * v[j].y) + (v[j].z * v[j].z + v[j].w * v[j].w); }
    s = wave_sum(s); if (lane < 8) ss[lane] = lane == 0 ? s : 0.f;
    u32x2* o8 = (u32x2*)orow + lane;
#pragma unroll
    for (int j = 0; j < 8; ++j) { u32x2 w; w.x = cvt_pk_bf16(v[j].x, v[j].y); w.y = cvt_pk_bf16(v[j].z, v[j].w); o8[64 * j] = w; }
}
typedef short bf16x8 __attribute__((ext_vector_type(8)));
typedef float f32x16 __attribute__((ext_vector_type(16)));
typedef __bf16 bf16x2_t __attribute__((ext_vector_type(2)));
__device__ __forceinline__ unsigned pk_bf16(float lo, float hi) { const f32x2v v = {lo, hi}; const bf16x2_t b = __builtin_convertvector(v, bf16x2_t); return __builtin_bit_cast(unsigned, b); }
__device__ __forceinline__ int crow(int i, int h) { return (i & 3) + 8 * (i >> 2) + 4 * h; }
#define MFMA32(a, b, c) __builtin_amdgcn_mfma_f32_32x32x16_bf16((a), (b), (c), 0, 0, 0)
__device__ __forceinline__ void attn_phase(LAS unsigned char* lds, const bf16_t* ZA, const f32x2v* rope, const float* qn, const float* kn, const float* sinks, bf16_t* Y, int G, int bid, int tid) {
    constexpr int KST = 144, VST = 520;
    LAS unsigned char* Kb = lds; LAS unsigned char* Vt = lds + 256 * KST;
    const int lane = tid & 63, wave = tid >> 6, r = lane & 31, h = lane >> 5;
    for (int u = bid; u < 512; u += G) {
        const int b = u >> 8, nb = (u >> 1) & 127, kvh = u & 1;
        __syncthreads();
        {
            const int j = tid & 255; const int t = nb * 128 - 128 + j; const bool isV = tid >= 256;
            u32x4 raw[8];
#pragma unroll
            for (int c = 0; c < 8; ++c) raw[c] = (u32x4){0u, 0u, 0u, 0u};
            if (t >= 0) { const bf16_t* src = ZA + (size_t)(b * SEQ + t) * 1280 + (isV ? 1152 : 1024) + kvh * 64;
#pragma unroll
                for (int c = 0; c < 8; ++c) raw[c] = ((const u32x4*)src)[c]; }
            if (isV) {
#pragma unroll
                for (int c = 0; c < 8; ++c)
#pragma unroll
                    for (int k = 0; k < 4; ++k) { const unsigned w = raw[c][k]; const int d = 8 * c + 2 * k;
                        *(LAS unsigned short*)(Vt + d * VST + 2 * j) = (unsigned short)(w & 0xffffu); *(LAS unsigned short*)(Vt + (d + 1) * VST + 2 * j) = (unsigned short)(w >> 16); }
            } else {
                float x[64];
#pragma unroll
                for (int c = 0; c < 8; ++c)
#pragma unroll
                    for (int k = 0; k < 4; ++k) { x[8 * c + 2 * k] = bf_lo(raw[c][k]); x[8 * c + 2 * k + 1] = bf_hi(raw[c][k]); }
                if (t >= 0) {
                    float ss = 0.f;
#pragma unroll
                    for (int i = 0; i < 64; ++i) ss += x[i] * x[i];
                    const float rstd = rsqrtf(ss * (1.0f / 64.0f) + 1e-6f);
#pragma unroll
                    for (int i = 0; i < 64; ++i) x[i] = x[i] * rstd * kn[i];
                    const f32x2v* cs = rope + (size_t)(b * SEQ + t) * 32;
#pragma unroll
                    for (int i = 0; i < 32; ++i) { const f32x2v c = cs[i]; const float x1 = x[i], x2 = x[i + 32]; x[i] = x1 * c.x - x2 * c.y; x[i + 32] = x2 * c.x + x1 * c.y; }
                }
#pragma unroll
                for (int c = 0; c < 8; ++c) { u32x4 w; w.x = pk_bf16(x[8 * c], x[8 * c + 1]); w.y = pk_bf16(x[8 * c + 2], x[8 * c + 3]); w.z = pk_bf16(x[8 * c + 4], x[8 * c + 5]); w.w = pk_bf16(x[8 * c + 6], x[8 * c + 7]);
                    *(LAS u32x4*)(Kb + j * KST + 16 * c) = w; }
            }
        }
        __syncthreads();
        const int hq = kvh * 8 + wave; const float sink = sinks[hq];
#pragma unroll 1
        for (int s = 0; s < 4; ++s) {
            const int iq = 32 * s + r; const size_t tokq = (size_t)b * SEQ + nb * 128 + iq;
            bf16x8 qf[4];
            {
                float x[4][8];
#pragma unroll
                for (int kk = 0; kk < 4; ++kk) { const u32x4 w = *(const u32x4*)(ZA + tokq * 1280 + hq * 64 + 16 * kk + 8 * h);
#pragma unroll
                    for (int k = 0; k < 4; ++k) { x[kk][2 * k] = bf_lo(w[k]); x[kk][2 * k + 1] = bf_hi(w[k]); } }
                float ss = 0.f;
#pragma unroll
                for (int kk = 0; kk < 4; ++kk)
#pragma unroll
                    for (int e = 0; e < 8; ++e) ss += x[kk][e] * x[kk][e];
                ss += __shfl_xor(ss, 32);
                const float rstd = rsqrtf(ss * (1.0f / 64.0f) + 1e-6f) * 0.125f;
#pragma unroll
                for (int kk = 0; kk < 4; ++kk)
#pragma unroll
                    for (int e = 0; e < 8; ++e) x[kk][e] = x[kk][e] * rstd * qn[16 * kk + 8 * h + e];
#pragma unroll
                for (int kk = 0; kk < 2; ++kk)
#pragma unroll
                    for (int e = 0; e < 8; ++e) { const f32x2v c = rope[tokq * 32 + 16 * kk + 8 * h + e]; const float x1 = x[kk][e], x2 = x[kk + 2][e]; x[kk][e] = x1 * c.x - x2 * c.y; x[kk + 2][e] = x2 * c.x + x1 * c.y; }
#pragma unroll
                for (int kk = 0; kk < 4; ++kk) { u32x4 w; w.x = pk_bf16(x[kk][0], x[kk][1]); w.y = pk_bf16(x[kk][2], x[kk][3]); w.z = pk_bf16(x[kk][4], x[kk][5]); w.w = pk_bf16(x[kk][6], x[kk][7]); qf[kk] = __builtin_bit_cast(bf16x8, w); }
            }
            f32x16 S[5];
#pragma unroll
            for (int t = 0; t < 5; ++t) { f32x16 acc;
#pragma unroll
                for (int i = 0; i < 16; ++i) acc[i] = 0.f;
#pragma unroll
                for (int kk = 0; kk < 4; ++kk) { const bf16x8 kf = *(const LAS bf16x8*)(Kb + (32 * (s + t) + r) * KST + 32 * kk + 16 * h); acc = MFMA32(kf, qf[kk], acc); }
                S[t] = acc; }
            if (nb > 0) {
#pragma unroll
                for (int i = 0; i < 16; ++i) { const bool up = crow(i, h) > r; S[0][i] = up ? S[0][i] : -INFINITY; S[4][i] = up ? -INFINITY : S[4][i]; }
            } else {
#pragma unroll
                for (int t = 0; t < 5; ++t)
#pragma unroll
                    for (int i = 0; i < 16; ++i) { const int j = 32 * (s + t) + crow(i, h); const bool ok = (j > iq) && (j <= iq + 128) && (j >= 128); S[t][i] = ok ? S[t][i] : -INFINITY; }
            }
            float mx = sink;
#pragma unroll
            for (int t = 0; t < 5; ++t)
#pragma unroll
                for (int i = 0; i < 16; ++i) mx = fmaxf(mx, S[t][i]);
            mx = fmaxf(mx, __shfl_xor(mx, 32));
            float sum = 0.f;
#pragma unroll
            for (int t = 0; t < 5; ++t)
#pragma unroll
                for (int i = 0; i < 16; ++i) { const float p = fast_exp(S[t][i] - mx); S[t][i] = p; sum += p; }
            sum += __shfl_xor(sum, 32); sum += fast_exp(sink - mx);
            f32x16 O0, O1;
#pragma unroll
            for (int i = 0; i < 16; ++i) { O0[i] = 0.f; O1[i] = 0.f; }
#pragma unroll
            for (int t = 0; t < 5; ++t)
#pragma unroll
                for (int ks = 0; ks < 2; ++ks) {
                    u32x4 pw; pw.x = pk_bf16(S[t][8 * ks], S[t][8 * ks + 1]); pw.y = pk_bf16(S[t][8 * ks + 2], S[t][8 * ks + 3]); pw.z = pk_bf16(S[t][8 * ks + 4], S[t][8 * ks + 5]); pw.w = pk_bf16(S[t][8 * ks + 6], S[t][8 * ks + 7]);
                    const bf16x8 pf = __builtin_bit_cast(bf16x8, pw);
                    const int key0 = 32 * (s + t) + 16 * ks + 4 * h;
                    const u32x2 a0 = *(const LAS u32x2*)(Vt + r * VST + 2 * key0), a1 = *(const LAS u32x2*)(Vt + r * VST + 2 * (key0 + 8));
                    const u32x2 c0 = *(const LAS u32x2*)(Vt + (r + 32) * VST + 2 * key0), c1 = *(const LAS u32x2*)(Vt + (r + 32) * VST + 2 * (key0 + 8));
                    const bf16x8 A0 = __builtin_bit_cast(bf16x8, ((u32x4){a0.x, a0.y, a1.x, a1.y})), A1 = __builtin_bit_cast(bf16x8, ((u32x4){c0.x, c0.y, c1.x, c1.y}));
                    O0 = MFMA32(A0, pf, O0); O1 = MFMA32(A1, pf, O1);
                }
            const float inv = 1.0f / sum;
            bf16_t* dst = Y + tokq * 1024 + hq * 64 + 4 * h;
#pragma unroll
            for (int gq = 0; gq < 4; ++gq) {
                u32x2 w0; w0.x = pk_bf16(O0[4 * gq] * inv, O0[4 * gq + 1] * inv); w0.y = pk_bf16(O0[4 * gq + 2] * inv, O0[4 * gq + 3] * inv); *(u32x2*)(dst + 8 * gq) = w0;
                u32x2 w1; w1.x = pk_bf16(O1[4 * gq] * inv, O1[4 * gq + 1] * inv); w1.y = pk_bf16(O1[4 * gq + 2] * inv, O1[4 * gq + 3] * inv); *(u32x2*)(dst + 32 + 8 * gq) = w1; }
        }
    }
}

template <int PASS> __device__ __forceinline__ void hgrn_phase(LAS unsigned char* lds, const bf16_t* ZH, const float* lbt, const float* hgn, float* SEGS, float* SEGD, bf16_t* Y, int G, int bid, int tid) {
    constexpr int O_TQ = 0, O_L0 = 2048, O_DEC = 2560, O_QD = 4096, O_KD = 21504, O_OF = 4096, O_QB = 38912, O_KUT = 56320, O_VT = 74752, O_AM = 93184;
    constexpr int RS = 272, TS = 144, FS = 528;
    LAS float* TQ = (LAS float*)(lds + O_TQ); LAS float* L0 = (LAS float*)(lds + O_L0); LAS float* DEC = (LAS float*)(lds + O_DEC);
    const int lane = tid & 63, wave = tid >> 6, r = lane & 31, h = lane >> 5, cb = wave >> 2, eb = wave & 3;
    const int d = tid & 127, tq = tid >> 7;
    for (int item = bid; item < 256; item += G) {
        const int b = item >> 7, hd = (item >> 4) & 7, seg = item & 15;
        const size_t tok0 = (size_t)b * SEQ + seg * 1024;
        const float lbv = 1.0f / (1.0f + expf(lbt[1024 + hd * 128 + d] - lbt[hd * 128 + d]));
        f32x16 St[4];
#pragma unroll
        for (int db = 0; db < 4; ++db)
#pragma unroll
            for (int i = 0; i < 16; ++i) St[db][i] = 0.f;
        if (PASS == 1) {
            f32x16 Pr[4];
#pragma unroll
            for (int db = 0; db < 4; ++db)
#pragma unroll
                for (int i = 0; i < 16; ++i) Pr[db][i] = 1.0f;
#pragma unroll 1
            for (int sp = seg - 1; sp >= 0; --sp) { const float* Se = SEGS + (size_t)(item - seg + sp) * 16384 + eb * 4096 + lane; const float* De = SEGD + (size_t)(item - seg + sp) * 128;
                float live = 0.f;
#pragma unroll
                for (int db = 0; db < 4; ++db)
#pragma unroll
                    for (int gq = 0; gq < 4; ++gq) { const f32x4 dv = *(const f32x4*)(De + 32 * db + 8 * gq + 4 * h);
#pragma unroll
                        for (int k = 0; k < 4; ++k) { St[db][4 * gq + k] += Pr[db][4 * gq + k] * Se[(db * 16 + 4 * gq + k) * 64]; Pr[db][4 * gq + k] *= dv[k]; live = fmaxf(live, Pr[db][4 * gq + k]); } }
                if (__ballot(live > 0.f) == 0ull) break;
            }
        }
        float Wd = 1.0f;
        LAS unsigned* FLG = (LAS unsigned*)(lds + 3072);
        if (tid == 0) { FLG[0] = 0u; FLG[1] = 0u; }
        unsigned short rq[16], rf[16], ri[16];
        {
            const bf16_t* zp = ZH + (tok0 + (PASS == 0 ? 960 : 0) + 16 * tq) * 4096 + hd * 128 + d;
#pragma unroll
            for (int t = 0; t < 16; ++t) { if (PASS == 1) rq[t] = zp[(size_t)t * 4096]; rf[t] = zp[(size_t)t * 4096 + 1024]; ri[t] = zp[(size_t)t * 4096 + 2048]; }
        }
        __syncthreads();
#pragma unroll 1
        for (int ci = 0; ci < 16; ++ci) {
            const int ch = PASS == 0 ? 15 - ci : ci;
            const size_t tokc = tok0 + 64 * ch;
            float bl[16], kk[16];
#pragma unroll
            for (int t = 0; t < 16; ++t) { const float fl = __uint_as_float((unsigned)rf[t] << 16); const float f = lbv + (1.0f - lbv) * fast_sigmoid(fl); bl[t] = f; kk[t] = 1.0f - f; }
            const float lf0 = bl[0];
#pragma unroll
            for (int t = 1; t < 16; ++t) bl[t] *= bl[t - 1];
            TQ[tq * 128 + d] = bl[15]; if (tq == 2) L0[d] = lf0;
            __syncthreads();
            {
                const float t0 = TQ[d], t1 = TQ[128 + d], t2 = TQ[256 + d], t3 = TQ[384 + d];
                const float off = tq == 0 ? 1.0f : (tq == 1 ? t0 : (tq == 2 ? t0 * t1 : t0 * t1 * t2));
                const float er = t0 * t1 * L0[d], edec = (t0 * t1) * (t2 * t3);
                const float rref = __builtin_amdgcn_rcpf(er), eu = edec * rref, offr = off * rref;
                if (PASS == 1 && tq == 0) DEC[d] = edec;
                const float wk = PASS == 0 ? eu * Wd : eu;
                if (PASS == 0) { Wd *= edec; if (tid == 0) FLG[(ci + 1) & 1] = 0u; if (__ballot(Wd > 0.f) != 0ull && lane == 0) FLG[ci & 1] = 1u; }
                unsigned kuw[8];
#pragma unroll
                for (int t = 0; t < 16; t += 2) {
                    float ku2[2];
#pragma unroll
                    for (int k = 0; k < 2; ++k) {
                        const float ed = offr * bl[t + k], ei = __builtin_amdgcn_rcpf(ed);
                        const float kd = kk[t + k] * ei; ku2[k] = kd * wk;
                        if (PASS == 1) {
                            const float qr = __uint_as_float((unsigned)rq[t + k] << 16); const float qd = fast_silu(qr) * ed;
                            const int row = (16 * tq + t + k) * RS + 2 * d;
                            *(LAS unsigned short*)(lds + O_QD + row) = (unsigned short)(pk_bf16(qd, 0.f) & 0xffffu);
                            *(LAS unsigned short*)(lds + O_KD + row) = (unsigned short)(pk_bf16(kd, 0.f) & 0xffffu);
                            *(LAS unsigned short*)(lds + O_QB + row) = (unsigned short)(pk_bf16(qd * er, 0.f) & 0xffffu);
                        }
                    }
                    kuw[t >> 1] = pk_bf16(ku2[0], ku2[1]);
                    *(LAS unsigned short*)(lds + O_VT + d * TS + 2 * (16 * tq + t)) = ri[t]; *(LAS unsigned short*)(lds + O_VT + d * TS + 2 * (16 * tq + t + 1)) = ri[t + 1];
                }
                *(LAS u32x4*)(lds + O_KUT + d * TS + 32 * tq) = (u32x4){kuw[0], kuw[1], kuw[2], kuw[3]}; *(LAS u32x4*)(lds + O_KUT + d * TS + 32 * tq + 16) = (u32x4){kuw[4], kuw[5], kuw[6], kuw[7]};
            }
            if (ci < 15) { const bf16_t* zp = ZH + (PASS == 0 ? tokc - 64 : tokc + 64) * 4096 + (size_t)(16 * tq) * 4096 + hd * 128 + d;
#pragma unroll
                for (int t = 0; t < 16; ++t) { if (PASS == 1) rq[t] = zp[(size_t)t * 4096]; rf[t] = zp[(size_t)t * 4096 + 1024]; ri[t] = zp[(size_t)t * 4096 + 2048]; } }
            u32x4 go0 = (u32x4){0u, 0u, 0u, 0u}, go1 = go0;
            if (PASS == 1) { const bf16_t* gp = ZH + (tokc + (tid >> 3)) * 4096 + 3072 + hd * 128 + 16 * (tid & 7); go0 = *(const u32x4*)gp; go1 = *(const u32x4*)(gp + 8); }
            __syncthreads();
            const bool alive = PASS == 1 || FLG[ci & 1] != 0u;
            bf16x8 vf[4];
#pragma unroll
            for (int ks = 0; ks < 4; ++ks) vf[ks] = *(const LAS bf16x8*)(lds + O_VT + (32 * eb + r) * TS + 32 * ks + 16 * h);
            if (PASS == 1) {
                if (wave < 4) {
                    const int sb = wave >> 1, cbk = wave & 1;
                    f32x16 acc;
#pragma unroll
                    for (int i = 0; i < 16; ++i) acc[i] = 0.f;
#pragma unroll
                    for (int ks = 0; ks < 8; ++ks) { const bf16x8 kdf = *(const LAS bf16x8*)(lds + O_KD + (32 * sb + r) * RS + 32 * ks + 16 * h), qdf = *(const LAS bf16x8*)(lds + O_QD + (32 * cbk + r) * RS + 32 * ks + 16 * h);
                        acc = MFMA32(kdf, qdf, acc); }
                    const int c = 32 * cbk + r;
#pragma unroll
                    for (int gq = 0; gq < 4; ++gq) { const int s0 = 32 * sb + 8 * gq + 4 * h;
                        const float a0 = (s0 <= c) ? acc[4 * gq] : 0.f, a1 = (s0 + 1 <= c) ? acc[4 * gq + 1] : 0.f, a2 = (s0 + 2 <= c) ? acc[4 * gq + 2] : 0.f, a3 = (s0 + 3 <= c) ? acc[4 * gq + 3] : 0.f;
                        u32x2 w; w.x = pk_bf16(a0, a1); w.y = pk_bf16(a2, a3); *(LAS u32x2*)(lds + O_AM + c * TS + 2 * s0) = w; }
                }
                __syncthreads();
                f32x16 acc;
#pragma unroll
                for (int i = 0; i < 16; ++i) acc[i] = 0.f;
#pragma unroll
                for (int ks = 0; ks < 4; ++ks) { const bf16x8 af = *(const LAS bf16x8*)(lds + O_AM + (32 * cb + r) * TS + 32 * ks + 16 * h); acc = MFMA32(af, vf[ks], acc); }
#pragma unroll
                for (int db = 0; db < 4; ++db)
#pragma unroll
                    for (int k2 = 0; k2 < 2; ++k2) {
                        u32x4 pw; pw.x = pk_bf16(St[db][8 * k2], St[db][8 * k2 + 1]); pw.y = pk_bf16(St[db][8 * k2 + 2], St[db][8 * k2 + 3]); pw.z = pk_bf16(St[db][8 * k2 + 4], St[db][8 * k2 + 5]); pw.w = pk_bf16(St[db][8 * k2 + 6], St[db][8 * k2 + 7]);
                        const int d0 = 32 * db + 16 * k2 + 4 * h;
                        const u32x2 q0 = *(const LAS u32x2*)(lds + O_QB + (32 * cb + r) * RS + 2 * d0), q1 = *(const LAS u32x2*)(lds + O_QB + (32 * cb + r) * RS + 2 * (d0 + 8));
                        acc = MFMA32(__builtin_bit_cast(bf16x8, ((u32x4){q0.x, q0.y, q1.x, q1.y})), __builtin_bit_cast(bf16x8, pw), acc);
                    }
#pragma unroll
                for (int i = 0; i < 16; ++i) *(LAS float*)(lds + O_OF + (32 * cb + crow(i, h)) * FS + 4 * (32 * eb + r)) = acc[i];
            }
#pragma unroll
            for (int db = 0; db < 4; ++db) {
                if (PASS == 1) {
#pragma unroll
                    for (int gq = 0; gq < 4; ++gq) { const f32x4 dv = *(const LAS f32x4*)(DEC + 32 * db + 8 * gq + 4 * h);
#pragma unroll
                        for (int k = 0; k < 4; ++k) St[db][4 * gq + k] *= dv[k]; }
                }
#pragma unroll
                for (int ks = 0; ks < 4; ++ks) { const bf16x8 kf = *(const LAS bf16x8*)(lds + O_KUT + (32 * db + r) * TS + 32 * ks + 16 * h); St[db] = MFMA32(kf, vf[ks], St[db]); }
            }
            if (PASS == 1) {
                __syncthreads();
                const int tk = tid >> 3, cg = tid & 7;
                f32x4 o[4];
#pragma unroll
                for (int k = 0; k < 4; ++k) o[k] = *(const LAS f32x4*)(lds + O_OF + tk * FS + 64 * cg + 16 * k);
                float ss = 0.f;
#pragma unroll
                for (int k = 0; k < 4; ++k) ss += (o[k].x * o[k].x + o[k].y * o[k].y) + (o[k].z * o[k].z + o[k].w * o[k].w);
                ss += __shfl_xor(ss, 1); ss += __shfl_xor(ss, 2); ss += __shfl_xor(ss, 4);
                const float rstd = rsqrtf(ss * (1.0f / 128.0f) + 1e-6f);
                const unsigned gw8[8] = {go0.x, go0.y, go0.z, go0.w, go1.x, go1.y, go1.z, go1.w};
                unsigned ow[8];
#pragma unroll
                for (int k = 0; k < 4; ++k) { const f32x4 gn = *(const f32x4*)(hgn + 16 * cg + 4 * k);
                    ow[2 * k] = pk_bf16(o[k].x * rstd * gn.x * fast_silu(bf_lo(gw8[2 * k])), o[k].y * rstd * gn.y * fast_silu(bf_hi(gw8[2 * k])));
                    ow[2 * k + 1] = pk_bf16(o[k].z * rstd * gn.z * fast_silu(bf_lo(gw8[2 * k + 1])), o[k].w * rstd * gn.w * fast_silu(bf_hi(gw8[2 * k + 1]))); }
                bf16_t* yp = Y + (tokc + tk) * 1024 + hd * 128 + 16 * cg;
                *(u32x4*)yp = (u32x4){ow[0], ow[1], ow[2], ow[3]}; *(u32x4*)(yp + 8) = (u32x4){ow[4], ow[5], ow[6], ow[7]};
            }
            if (!alive) break;
        }
        if (PASS == 0) {
            if (cb == 0) { float* Se = SEGS + (size_t)item * 16384 + eb * 4096 + lane;
#pragma unroll
                for (int db = 0; db < 4; ++db)
#pragma unroll
                    for (int i = 0; i < 16; ++i) Se[(db * 16 + i) * 64] = St[db][i]; }
            if (tq == 0) SEGD[(size_t)item * 128 + d] = Wd;
        }
        __syncthreads();
    }
}

#define XB_TMO      128
#define XB_XCNT(j)  (256  + 64 * (j))
#define XB_XSUB(j)  (1280 + 64 * (j))
#define XB_XGEN(j)  (2304 + 64 * (j))
#define XB_TOP      3328
#define XB_TOPGEN   3392
#define XCD_BAR_WORDS 3456
#define XB_SPIN_CAP (1u << 18)

__device__ __forceinline__ unsigned xb_ld(unsigned* p)              { return __hip_atomic_load(p, __ATOMIC_RELAXED, __HIP_MEMORY_SCOPE_AGENT); }
__device__ __forceinline__ unsigned xb_add(unsigned* p, unsigned v) { return __hip_atomic_fetch_add(p, v, __ATOMIC_RELAXED, __HIP_MEMORY_SCOPE_AGENT); }
__device__ __forceinline__ unsigned xb_xcc_id() { return (unsigned)__builtin_amdgcn_s_getreg((3 << 11) | 20) & 0xFu; }
#define XB_SPIN(cond, bar) do { unsigned _sp = 0; while (cond) { __builtin_amdgcn_s_sleep(1); \
    if ((++_sp & 255u) == 0u) { if (xb_ld(&(bar)[XB_TMO])) break; if (_sp > XB_SPIN_CAP) { atomicAdd(&(bar)[XB_TMO], 1u); break; } } } } while (0)

struct XcdBarrier {
    unsigned* bar; unsigned x;
    volatile LAS unsigned* st;
};

__device__ __forceinline__ XcdBarrier xcd_barrier_post(unsigned* bar, volatile LAS unsigned* st) {
    XcdBarrier b; b.bar = bar; b.x = xb_xcc_id(); b.st = st;
    if (threadIdx.x == 0) (void)xb_add(&bar[XB_XCNT(b.x)], 1u);
    return b;
}
__device__ __forceinline__ void xcd_barrier_complete(unsigned* bar, unsigned x, unsigned& nloc, unsigned& nx) {
    const unsigned G = gridDim.x * gridDim.y * gridDim.z;
    unsigned sum, cnt, mine, sp = 0u;
    for (;;) {
        sum = 0u; cnt = 0u; mine = 0u;
#pragma unroll
        for (unsigned j = 0; j < 16; ++j) { const unsigned c = xb_ld(&bar[XB_XCNT(j)]); sum += c; cnt += (c > 0u) ? 1u : 0u; mine = (j == x) ? c : mine; }
        if (sum == G) break;
        __builtin_amdgcn_s_sleep(1);
        if ((++sp & 255u) == 0u) { if (xb_ld(&bar[XB_TMO])) break; if (sp > XB_SPIN_CAP) { atomicAdd(&bar[XB_TMO], 1u); break; } }
    }
    nloc = mine > 0u ? mine : 1u; nx = cnt > 0u ? cnt : 1u;
}

__device__ __forceinline__ void xcd_barrier(const XcdBarrier& b) {
    asm volatile("s_waitcnt vmcnt(0)" ::: "memory");
    __syncthreads();
    if (threadIdx.x == 0) {
        unsigned* bar = b.bar;
        __builtin_amdgcn_s_waitcnt(0);
        unsigned nloc = b.st[0], nx = b.st[1];
        if (nloc == 0u) { xcd_barrier_complete(bar, b.x, nloc, nx); b.st[0] = nloc; b.st[1] = nx; }
        const unsigned old = xb_add(&bar[XB_XSUB(b.x)], 1u);
        const unsigned gen = old / nloc;
        if (old + 1u == (gen + 1u) * nloc) {
            __builtin_amdgcn_fence(__ATOMIC_RELEASE, "agent");
            asm volatile("s_waitcnt vmcnt(0)" ::: "memory");
            const unsigned og = xb_add(&bar[XB_TOP], 1u);
            const unsigned tg = og / nx;
            if (og + 1u == (tg + 1u) * nx) xb_add(&bar[XB_TOPGEN], 1u);
            else XB_SPIN(xb_ld(&bar[XB_TOPGEN]) == tg, bar);
            __builtin_amdgcn_fence(__ATOMIC_ACQUIRE, "agent");
            xb_add(&bar[XB_XGEN(b.x)], 1u);
            asm volatile("s_waitcnt vmcnt(0)" ::: "memory");
        } else {
            XB_SPIN(xb_ld(&bar[XB_XGEN(b.x)]) == gen, bar);
            __builtin_amdgcn_fence(__ATOMIC_ACQUIRE, "agent");
            asm volatile("s_waitcnt vmcnt(0)" ::: "memory");
        }
    }
    __syncthreads();
}

__global__ void __launch_bounds__(NTHREADS, 2) fwd_megakernel(Args a) {
    extern __shared__ __attribute__((aligned(16))) unsigned char lds_raw[];
    LAS unsigned char* lds = (LAS unsigned char*)lds_raw;
    cg::grid_group grid = cg::this_grid();
    const int tid = threadIdx.x, lane = tid & 63, wave = __builtin_amdgcn_readfirstlane(tid >> 6);
    const int G = gridDim.x, bid = blockIdx.x;
    const int gw = bid * NWAVES + wave, ngw = G * NWAVES;
    unsigned char* ws = a.ws;
    bf16_t* WGU1 = (bf16_t*)(ws + WS_WGU1); bf16_t* WD1 = (bf16_t*)(ws + WS_WD1); bf16_t* WIN = (bf16_t*)(ws + WS_WIN); bf16_t* WAR = (bf16_t*)(ws + WS_WAR);
    bf16_t* WOUT = (bf16_t*)(ws + WS_WOUT); bf16_t* WGU2 = (bf16_t*)(ws + WS_WGU2); bf16_t* WD2 = (bf16_t*)(ws + WS_WD2);
    f32x2v* ROPE = (f32x2v*)(ws + WS_ROPE); float* SEGS = (float*)(ws + WS_SEGS); float* SEGD = (float*)(ws + WS_SEGD);
    bf16_t* H = (bf16_t*)(ws + WS_H); bf16_t* ZA = (bf16_t*)(ws + WS_ZA); bf16_t* ZH = (bf16_t*)(ws + WS_ZH); bf16_t* ZG = (bf16_t*)(ws + WS_ZG);
    float* SS1 = (float*)(ws + WS_SS);
    bf16_t* HID = (bf16_t*)(ws + WS_HID); bf16_t* MRG = (bf16_t*)(ws + WS_MRG); bf16_t* YA = (bf16_t*)a.out; bf16_t* YR = YA + (size_t)TT * 1024;
    const int lo = a.ph_lo, hi = a.ph_hi;
    const int p4_rem = ((TT / 256) * (NIN / 256)) % G; const bool ffn2_deferred = p4_rem != 0;
    volatile LAS unsigned* MISC = (volatile LAS unsigned*)(lds + LDS_BYTES - 64);
    if (tid < 16) MISC[tid] = 0u;
    __syncthreads();
    const XcdBarrier xbar = xcd_barrier_post((unsigned*)ws, MISC + 8);
#ifndef TESTMASK
#define TESTMASK 0xfff
#endif
#define IN(k) (((TESTMASK >> (k)) & 1) && lo <= (k) && (k) < hi)
#define SEAM(k) do { if (lo <= (k) && (k) + 1 < hi) xcd_barrier(xbar); } while (0)
    if (hi > 1000) grid.sync();

    if (IN(0)) {
        LAS float* scr = (LAS float*)(lds + wave * 16384);
        constexpr int I_GU = (DM / 64) * (NGU / 32), I_D = (DFF / 64) * (DM / 32), I_IN = (DM / 64) * (NIN / 32), I_BR = (1024 / 64) * (DM / 32), I_O = (DM / 64) * (DM / 32);
        constexpr int NITEMS = I_GU + I_D + I_IN;
        for (int it = gw; it < NITEMS; it += ngw) {
            int r = it;
            if (r < I_GU) { transpose_item<1>(a.wgu1, DM, NGU, WGU1, DM, 0, a.n1, scr, r, lane); continue; } r -= I_GU;
            if (r < I_D) { transpose_item<0>(a.wd1, DFF, DM, WD1, DFF, 0, nullptr, scr, r, lane); continue; } r -= I_D;
            transpose_item<2>(a.win, DM, NIN, WIN, DM, 0, a.nmix, scr, r - 0, lane);
        }
        if (!ffn2_deferred)
            for (int it = gw; it < 2 * I_BR + I_O + I_GU + I_D; it += ngw) { int r = it;
                if (r < I_BR) { transpose_item<0>(a.wa, 1024, DM, WAR, 1024, 0, nullptr, scr, r, lane); continue; } r -= I_BR;
                if (r < I_BR) { transpose_item<0>(a.wr, 1024, DM, WAR + (size_t)DM * 1024, 1024, 0, nullptr, scr, r, lane); continue; } r -= I_BR;
                if (r < I_O) { transpose_item<0>(a.wout, DM, DM, WOUT, DM, 0, nullptr, scr, r, lane); continue; } r -= I_O;
                if (r < I_GU) { transpose_item<1>(a.wgu2, DM, NGU, WGU2, DM, 0, a.n2, scr, r, lane); continue; } r -= I_GU;
                transpose_item<0>(a.wd2, DFF, DM, WD2, DFF, 0, nullptr, scr, r, lane); }
        for (int idx = bid * NTHREADS + tid; idx < TT * 32; idx += G * NTHREADS) {
            const int tok = idx >> 5, i = idx & 31;
            const float inv_freq = exp2f(-(float)i * 0.41524101186092029f);
            const float ang = (float)a.pos[tok] * inv_freq;
            double rev = (double)ang * 0.15915494309189535; rev -= rint(rev);
            const float fr = (float)rev;
            ROPE[idx] = (f32x2v){__builtin_amdgcn_cosf(fr), __builtin_amdgcn_sinf(fr)};
        }
        for (int m = gw; m < TT; m += ngw) row_to_bf16_ss(a.x + (size_t)m * DM, H + (size_t)m * DM, SS1 + (size_t)m * 8, lane);
    }
    SEAM(0);
    if (IN(1)) { __syncthreads(); pg8::Gemm g{H, WGU1, TT, NGU, DM}; pg8::StaticOrder S; S.init(TT, NGU, G, bid); pg8::EpiSwiglu E{ws, 0};
        pg8::gemm_phase<pg8::EpiSwiglu, pg8::StaticOrder, true, true>(lds, g, S, E); }
    SEAM(1);
    if (IN(2)) { __syncthreads(); pg8::Gemm g{HID, WD1, TT, DM, DFF}; pg8::StaticOrder S; S.init(TT, DM, G, bid); pg8::EpiResidB<0> E{a.out, 0.5f, ws, 1, (LAS float*)(lds + 131072)};
        pg8::gemm_phase<pg8::EpiResidB<0>, pg8::StaticOrder, true, true>(lds, g, S, E); }
    SEAM(2);
    if (IN(4)) { __syncthreads(); pg8::Gemm g{H, WIN, TT, NIN, DM}; pg8::StaticOrder S; S.init(TT, NIN, G, bid); pg8::EpiZ E{ws};
        pg8::gemm_phase<pg8::EpiZ, pg8::StaticOrder, true, true>(lds, g, S, E);
        if (ffn2_deferred && bid >= p4_rem) {
            __syncthreads();
            LAS float* scr = (LAS float*)(lds + wave * 16384);
            constexpr int I_GU = (DM / 64) * (NGU / 32), I_D = (DFF / 64) * (DM / 32), I_BR = (1024 / 64) * (DM / 32), I_O = (DM / 64) * (DM / 32);
            const int gw2 = (bid - p4_rem) * NWAVES + wave, ngw2 = (G - p4_rem) * NWAVES;
            for (int it = gw2; it < 2 * I_BR + I_O + I_GU + I_D; it += ngw2) { int r = it;
                if (r < I_BR) { transpose_item<0, true>(a.wa, 1024, DM, WAR, 1024, 0, nullptr, scr, r, lane); continue; } r -= I_BR;
                if (r < I_BR) { transpose_item<0, true>(a.wr, 1024, DM, WAR + (size_t)DM * 1024, 1024, 0, nullptr, scr, r, lane); continue; } r -= I_BR;
                if (r < I_O) { transpose_item<0, true>(a.wout, DM, DM, WOUT, DM, 0, nullptr, scr, r, lane); continue; } r -= I_O;
                if (r < I_GU) { transpose_item<1, true>(a.wgu2, DM, NGU, WGU2, DM, 0, a.n2, scr, r, lane); continue; } r -= I_GU;
                transpose_item<0, true>(a.wd2, DFF, DM, WD2, DFF, 0, nullptr, scr, r, lane); }
        } }
    SEAM(4);
    if (IN(5)) { __syncthreads();
#ifndef NOHG0
        hgrn_phase<0>(lds, ZH, a.lb, a.hgn, SEGS, SEGD, YR, G, bid, tid);
#endif
#ifndef NOATTN
        attn_phase(lds, ZA, ROPE, a.qn, a.kn, a.sinks, YA, G, bid, tid);
#endif
    }
    SEAM(5);
    if (IN(6)) { __syncthreads(); hgrn_phase<1>(lds, ZH, a.lb, a.hgn, SEGS, SEGD, YR, G, bid, tid); }
    SEAM(6);
    if (IN(7)) { __syncthreads(); pg8::DualOrder S; S.base.init(TT, DM, G, bid);
        pg8::Gemm g{YA, WAR, TT, DM, 1024, YR, WAR + (size_t)DM * 1024}; pg8::EpiMerge E{ws};
        pg8::gemm_phase<pg8::EpiMerge, pg8::DualOrder, true, true>(lds, g, S, E); }
    SEAM(7);
    if (IN(8)) { __syncthreads(); pg8::Gemm g{MRG, WOUT, TT, DM, DM}; pg8::StaticOrder S; S.init(TT, DM, G, bid); pg8::EpiResidB<0> E{a.out, 1.0f, ws, 2, (LAS float*)(lds + 131072)};
        pg8::gemm_phase<pg8::EpiResidB<0>, pg8::StaticOrder, true, true>(lds, g, S, E); }
    SEAM(8);
    if (IN(10)) { __syncthreads(); pg8::Gemm g{H, WGU2, TT, NGU, DM}; pg8::StaticOrder S; S.init(TT, NGU, G, bid); pg8::EpiSwiglu E{ws, 2};
        pg8::gemm_phase<pg8::EpiSwiglu, pg8::StaticOrder, true, true>(lds, g, S, E); }
    SEAM(10);
    if (IN(11)) { __syncthreads(); pg8::Gemm g{HID, WD2, TT, DM, DFF}; pg8::StaticOrder S; S.init(TT, DM, G, bid); pg8::EpiResidB<1> E{a.out, 0.5f, ws, 0, (LAS float*)(lds + 131072)};
        pg8::gemm_phase<pg8::EpiResidB<1>, pg8::StaticOrder, true, true>(lds, g, S, E); }
#undef IN
#undef SEAM
}

#ifndef MK_MULTI
#define MK_MULTI 0
#endif
extern "C" void kernel_launch(void* const* d_in, const int* in_sizes, int n_in, void* d_out, int out_size, void* d_ws, size_t ws_size, hipStream_t stream) {
    static int grid = 0;
    if (grid == 0) {
        if (n_in != 18 || out_size != TT * DM || ws_size < WS_END) { fprintf(stderr, "kernel_launch: unexpected shapes (n_in %d out %d ws %zu)\n", n_in, out_size, ws_size); grid = -1; return; }
        int dev = 0, cus = 0, per_cu = 0;
        (void)hipGetDevice(&dev); (void)hipDeviceGetAttribute(&cus, hipDeviceAttributeMultiprocessorCount, dev);
        (void)hipFuncSetAttribute((const void*)fwd_megakernel, hipFuncAttributeMaxDynamicSharedMemorySize, LDS_BYTES);
        if (hipOccupancyMaxActiveBlocksPerMultiprocessor(&per_cu, (const void*)fwd_megakernel, NTHREADS, LDS_BYTES) != hipSuccess || per_cu < 1) { per_cu = 1; (void)hipGetLastError(); }
        grid = cus * 1;
        if (grid <= 0) grid = 256;
    }
    if (grid < 0) return;
    (void)hipMemsetAsync(d_ws, 0, 16384, stream);
    Args a{};
    a.x = (const float*)d_in[0]; a.pos = (const int*)d_in[1]; a.lb = (const float*)d_in[2]; a.n1 = (const float*)d_in[3]; a.wgu1 = (const float*)d_in[4]; a.wd1 = (const float*)d_in[5];
    a.nmix = (const float*)d_in[6]; a.win = (const float*)d_in[7]; a.qn = (const float*)d_in[8]; a.kn = (const float*)d_in[9]; a.sinks = (const float*)d_in[10]; a.hgn = (const float*)d_in[11];
    a.wa = (const float*)d_in[12]; a.wr = (const float*)d_in[13]; a.wout = (const float*)d_in[14]; a.n2 = (const float*)d_in[15]; a.wgu2 = (const float*)d_in[16]; a.wd2 = (const float*)d_in[17];
    a.out = (float*)d_out; a.ws = (unsigned char*)d_ws;
#if MK_MULTI
    for (int p = 0; p < 12; ++p) { a.ph_lo = p; a.ph_hi = p + 1; hipLaunchKernelGGL(fwd_megakernel, dim3(grid), dim3(NTHREADS), LDS_BYTES, stream, a); }
#else
    a.ph_lo = 0; a.ph_hi = 12;
    void* args[] = {&a};
    hipError_t e = hipLaunchCooperativeKernel((const void*)fwd_megakernel, dim3(grid), dim3(NTHREADS), args, LDS_BYTES, stream);
    if (e != hipSuccess) fprintf(stderr, "cooperative launch failed: %s (grid %d)\n", hipGetErrorString(e), grid);
#endif
}
```
